# Optimizing an MI355X kernel written in HIP

```python
import jax, jax.numpy as jnp
from jax import lax
import numpy as np

D_MODEL = 1024
BATCH = 16
SEQ = 4096
DEPTH = 2

GRID_W = 64
N_META = 16
N_MIXERS = 2
NA_HEADS = 16
NA_HEAD_DIM = D_MODEL // NA_HEADS
NA_WIN_ROWS = 8
NA_WIN_COLS = 16
GQA_HEADS = 16
GQA_KV_HEADS = 4
GQA_GROUP = GQA_HEADS // GQA_KV_HEADS
GQA_HEAD_DIM = D_MODEL // GQA_HEADS
Q_BLOCK = 128
ROPE_THETA = 10000.0
D_FF = 2816
RMS_EPS = 1e-6
N_NA_LAYERS = (DEPTH + 1) // 2
N_GQA_LAYERS = DEPTH // 2

kernel_name = "hybrid_natten_gqa_macaron_encoder"


def rms_norm(x, gain):
    xf = x.astype(jnp.float32)
    y = xf * lax.rsqrt(jnp.mean(xf * xf, axis=-1, keepdims=True) + RMS_EPS)
    return (y * gain.astype(jnp.float32)).astype(x.dtype)


def swiglu(x, w_gate, w_up, w_down):
    return (jax.nn.silu(x @ w_gate) * (x @ w_up)) @ w_down


def neighborhood_attention(h, w_qkv, w_o, rpb, meta_bias):
    b, l, d = h.shape
    n = l - N_META
    rows = n // GRID_W
    kh = min(NA_WIN_ROWS, rows)
    kw = NA_WIN_COLS
    qkv = (h @ w_qkv).reshape(b, l, 3, NA_HEADS, NA_HEAD_DIM)
    q = qkv[:, :, 0] * (NA_HEAD_DIM ** -0.5)
    k = qkv[:, :, 1]
    v = qkv[:, :, 2]
    q_m, k_m, v_m = q[:, :N_META], k[:, :N_META], v[:, :N_META]
    q_g = q[:, N_META:].reshape(b, rows, GRID_W, NA_HEADS, NA_HEAD_DIM)
    k_g = k[:, N_META:].reshape(b, rows, GRID_W, NA_HEADS, NA_HEAD_DIM)
    v_g = v[:, N_META:].reshape(b, rows, GRID_W, NA_HEADS, NA_HEAD_DIM)

    s_mm = jnp.einsum('bqhd,bkhd->bhqk', q_m, k_m).astype(jnp.float32)
    p_mm = jax.nn.softmax(s_mm, axis=-1).astype(v.dtype)
    o_meta = jnp.einsum('bhqk,bkhd->bqhd', p_mm, v_m).reshape(b, N_META, d)

    cols = np.arange(GRID_W)
    col_start = np.clip(cols - kw // 2, 0, GRID_W - kw)
    col_idx = col_start[:, None] + np.arange(kw)[None, :]
    col_rel = col_idx - cols[:, None] + (NA_WIN_COLS - 1)
    rpb_cols = rpb[:, :, col_rel].astype(jnp.float32)
    mbias = meta_bias.astype(jnp.float32)[None, :, None, :]

    def row_block(r):
        rs = jnp.clip(r - kh // 2, 0, rows - kh)
        q_r = lax.dynamic_index_in_dim(q_g, r, axis=1, keepdims=False)
        k_band = lax.dynamic_slice_in_dim(k_g, rs, kh, axis=1)
        v_band = lax.dynamic_slice_in_dim(v_g, rs, kh, axis=1)
        k_win = k_band[:, :, col_idx]
        v_win = v_band[:, :, col_idx]
        row_rel = rs + jnp.arange(kh) - r + (NA_WIN_ROWS - 1)
        bias = jnp.take(rpb_cols, row_rel, axis=1).transpose(0, 2, 1, 3)
        s_win = jnp.einsum('bchd,brcjhd->bhcrj', q_r, k_win).astype(jnp.float32) + bias[None]
        s_win = s_win.reshape(b, NA_HEADS, GRID_W, kh * kw)
        s_meta = jnp.einsum('bchd,bmhd->bhcm', q_r, k_m).astype(jnp.float32) + mbias
        p = jax.nn.softmax(jnp.concatenate([s_meta, s_win], axis=-1), axis=-1).astype(v.dtype)
        p_meta = p[..., :N_META]
        p_win = p[..., N_META:].reshape(b, NA_HEADS, GRID_W, kh, kw)
        return (jnp.einsum('bhcm,bmhd->bchd', p_meta, v_m)
                + jnp.einsum('bhcrj,brcjhd->bchd', p_win, v_win))

    o_grid = lax.map(row_block, jnp.arange(rows))
    o_grid = jnp.moveaxis(o_grid, 0, 1).reshape(b, n, d)
    o = jnp.concatenate([o_meta, o_grid], axis=1)
    return o @ w_o


def axial_rope_tables(n):
    t = jnp.arange(n)
    row = (t // GRID_W).astype(jnp.float32)
    col = (t % GRID_W).astype(jnp.float32)
    sec = GQA_HEAD_DIM // 2
    freqs = ROPE_THETA ** (-jnp.arange(0, sec, 2, dtype=jnp.float32) / sec)
    ang = jnp.concatenate([row[:, None] * freqs, col[:, None] * freqs], axis=-1)
    ang = jnp.concatenate([jnp.zeros((N_META, sec), jnp.float32), ang], axis=0)
    ang = ang.reshape(N_META + n, 2, sec // 2)
    return jnp.cos(ang), jnp.sin(ang)


def apply_axial_rope(x, cos, sin):
    quarter = GQA_HEAD_DIM // 4
    xs = x.astype(jnp.float32).reshape(*x.shape[:-1], 2, 2, quarter)
    x1, x2 = xs[..., 0, :], xs[..., 1, :]
    c = cos[None, :, None]
    s = sin[None, :, None]
    out = jnp.stack([x1 * c - x2 * s, x2 * c + x1 * s], axis=-2)
    return out.reshape(x.shape).astype(x.dtype)


def grouped_query_attention(h, w_qkv, w_o, q_gain, k_gain):
    b, l, d = h.shape
    n = l - N_META
    nq = GQA_HEADS * GQA_HEAD_DIM
    nkv = GQA_KV_HEADS * GQA_HEAD_DIM
    qkv = h @ w_qkv
    q = qkv[..., :nq].reshape(b, l, GQA_HEADS, GQA_HEAD_DIM)
    k = qkv[..., nq:nq + nkv].reshape(b, l, GQA_KV_HEADS, GQA_HEAD_DIM)
    v = qkv[..., nq + nkv:].reshape(b, l, GQA_KV_HEADS, GQA_HEAD_DIM)
    q = rms_norm(q, q_gain)
    k = rms_norm(k, k_gain)
    cos, sin = axial_rope_tables(n)
    q = apply_axial_rope(q, cos, sin) * (GQA_HEAD_DIM ** -0.5)
    k = apply_axial_rope(k, cos, sin)
    q = q.reshape(b, l, GQA_KV_HEADS, GQA_GROUP, GQA_HEAD_DIM)

    def attend(q_blk):
        s = jnp.einsum('bqkgd,bskd->bkgqs', q_blk, k).astype(jnp.float32)
        p = jax.nn.softmax(s, axis=-1).astype(v.dtype)
        return jnp.einsum('bkgqs,bskd->bqkgd', p, v)

    o_meta = attend(q[:, :N_META]).reshape(b, N_META, nq)
    q_blocks = q[:, N_META:].reshape(b, n // Q_BLOCK, Q_BLOCK, GQA_KV_HEADS, GQA_GROUP, GQA_HEAD_DIM)
    o_blocks = lax.map(attend, jnp.swapaxes(q_blocks, 0, 1))
    o_real = jnp.swapaxes(o_blocks, 0, 1).reshape(b, n, nq)
    o = jnp.concatenate([o_meta, o_real], axis=1)
    return o @ w_o


def setup_inputs(seed: int = 0) -> dict:
    key = jax.random.key(seed)
    ks = jax.random.split(key, 16)
    f32 = jnp.float32
    d, f = D_MODEL, D_FF
    nq = GQA_HEADS * GQA_HEAD_DIM
    nkv = GQA_KV_HEADS * GQA_HEAD_DIM
    return {
        "x": jax.random.normal(ks[0], (BATCH, SEQ, d), f32),
        "meta_tokens": jax.random.normal(ks[1], (N_META, d), f32),
        "norm_gains": 1.0 + 0.05 * jax.random.normal(ks[2], (DEPTH, 6, d), f32),
        "ffn_w_gate": jax.random.normal(ks[3], (DEPTH, 2, d, f), f32) * d ** -0.5,
        "ffn_w_up": jax.random.normal(ks[4], (DEPTH, 2, d, f), f32) * d ** -0.5,
        "ffn_w_down": jax.random.normal(ks[5], (DEPTH, 2, f, d), f32) * f ** -0.5,
        "na_w_qkv": jax.random.normal(ks[6], (N_NA_LAYERS, d, 3 * d), f32) * d ** -0.5,
        "na_w_o": jax.random.normal(ks[7], (N_NA_LAYERS, d, d), f32) * d ** -0.5,
        "na_rpb": 0.1 * jax.random.normal(ks[8], (N_NA_LAYERS, NA_HEADS, 2 * NA_WIN_ROWS - 1, 2 * NA_WIN_COLS - 1), f32),
        "na_meta_bias": 0.1 * jax.random.normal(ks[9], (N_NA_LAYERS, NA_HEADS, N_META), f32),
        "gqa_w_qkv": jax.random.normal(ks[10], (N_GQA_LAYERS, d, nq + 2 * nkv), f32) * d ** -0.5,
        "gqa_w_o": jax.random.normal(ks[11], (N_GQA_LAYERS, nq, d), f32) * nq ** -0.5,
        "gqa_q_gain": 1.0 + 0.05 * jax.random.normal(ks[12], (N_GQA_LAYERS, GQA_HEAD_DIM), f32),
        "gqa_k_gain": 1.0 + 0.05 * jax.random.normal(ks[13], (N_GQA_LAYERS, GQA_HEAD_DIM), f32),
    }


def reference(x, meta_tokens, norm_gains, ffn_w_gate, ffn_w_up, ffn_w_down,
              na_w_qkv, na_w_o, na_rpb, na_meta_bias,
              gqa_w_qkv, gqa_w_o, gqa_q_gain, gqa_k_gain):
    b = x.shape[0]
    meta = jnp.broadcast_to(meta_tokens[None].astype(x.dtype), (b, N_META, D_MODEL))
    h = jnp.concatenate([meta, x], axis=1)
    for i in range(DEPTH):
        g = norm_gains[i]
        ff = swiglu(rms_norm(h, g[0]), ffn_w_gate[i, 0], ffn_w_up[i, 0], ffn_w_down[i, 0])
        h = h + 0.5 * rms_norm(ff, g[1])
        m_in = rms_norm(h, g[2])
        j = i // N_MIXERS
        if i % N_MIXERS == 0:
            m = neighborhood_attention(m_in, na_w_qkv[j], na_w_o[j], na_rpb[j], na_meta_bias[j])
        else:
            m = grouped_query_attention(m_in, gqa_w_qkv[j], gqa_w_o[j], gqa_q_gain[j], gqa_k_gain[j])
        h = h + rms_norm(m, g[3])
        ff = swiglu(rms_norm(h, g[4]), ffn_w_gate[i, 1], ffn_w_up[i, 1], ffn_w_down[i, 1])
        h = h + 0.5 * rms_norm(ff, g[5])
    return h[:, N_META:]
```

```cpp
#include <hip/hip_runtime.h>
#include <hip/hip_cooperative_groups.h>
#include <cstdio>
#include <cstdint>
namespace cg = cooperative_groups;
#ifndef MK_ONE_LAUNCH
#define MK_ONE_LAUNCH 1
#endif
#ifndef NA_FAST
#define NA_FAST 1
#endif
#ifndef GQA_FAST
#define GQA_FAST 1
#endif
#ifndef DUP_MASK
#define DUP_MASK 0u
#endif
#ifndef DUP_VARIANT
#define DUP_VARIANT 0
#endif
namespace pg8 {
#define PG8_LAS __attribute__((address_space(3)))
typedef unsigned short bf16_t;
typedef short bf16x8 __attribute__((ext_vector_type(8)));
typedef float f32x4 __attribute__((ext_vector_type(4)));
typedef unsigned u32x4 __attribute__((ext_vector_type(4)));
constexpr int BM = 256, BK = 64, HALF = 128, HTB = HALF * BK * 2  , STAGE_BYTES = 8 * HTB, NXCD = 8, WGM = 8;

__host__ __device__ __forceinline__ int lds_byte(int r, int c) { const int st = (r >> 4) * 2 + (c >> 5), rr = r & 15, cc = c & 31, ob = rr * 64 + cc * 2; return st * 1024 + (ob ^ (((ob >> 9) & 1) << 5)); }
__host__ __device__ __forceinline__ void stage_rc(int b, int& R, int& C) { const int st = b / 1024, sb = b % 1024, swz = sb ^ (((sb >> 9) & 1) << 5); R = (st >> 1) * 16 + swz / 64; C = (st & 1) * 32 + (swz % 64) / 2; }
__host__ __device__ __forceinline__ int perm32(int rho) { const int n = rho >> 4, i = rho & 15; return 8 * (i >> 2) + 4 * n + (i & 3); }

struct Unit { int pm, pn; };
struct Gemm { const bf16_t* A; const bf16_t* Bt; int M, N, K; };

struct StaticOrder {
    int nM, nN, nwg, G, c;
    __host__ __device__ void init(int M, int N, int G_, int c_) { nM = M / BM; nN = N / BM; nwg = nM * nN; G = G_; c = c_; }
    __host__ __device__ bool next(int i, Unit& u) const {
        const long L = (long)i * G + c; if (L >= nwg) return false;
        int wgid = (int)L; { const int q = nwg / NXCD, r = nwg % NXCD, xcd = wgid % NXCD, off = wgid / NXCD; wgid = (xcd < r ? xcd * (q + 1) : r * (q + 1) + (xcd - r) * q) + off; }
        const int nig = WGM * nN, gid = wgid / nig, fm = gid * WGM, gsz = (nM - fm) < WGM ? (nM - fm) : WGM;
        u.pm = fm + ((wgid % nig) % gsz); u.pn = (wgid % nig) / gsz; return true;
    }
    __device__ __forceinline__ void a_ready(const Unit&) const {}
    __device__ __forceinline__ void done(const Unit&) const {}
};

__device__ __forceinline__ unsigned cvt_pk_bf16(float lo, float hi) { unsigned r; asm volatile("v_cvt_pk_bf16_f32 %0, %1, %2" : "=v"(r) : "v"(lo), "v"(hi)); return r; }
template <class Epi, class Sched, bool ALIGN_EPI = false, bool SP2 = false>
__device__ __forceinline__ void gemm_phase(PG8_LAS unsigned char* lds, const Gemm g, const Sched& S, const Epi& E, const int tid) {
    const int wid = __builtin_amdgcn_readfirstlane(tid >> 6), lane = tid & 63, wr = wid >> 2, wc = wid & 3, fr = lane & 15, fq = lane >> 4;
    const int K = g.K, nt = K / BK;
    unsigned voffA[2], voffB[2];
#pragma unroll
    for (int i = 0; i < 2; ++i) { int R, C; stage_rc(tid * 16 + i * 8192, R, C); const int Rb = Epi::PERM ? ((R & ~31) + perm32(R & 31)) : R;
        voffA[i] = (unsigned)(R * K + C) * 2u; voffB[i] = (unsigned)(Rb * K + C) * 2u; }
    const size_t kstep = (size_t)(BK * 2);
    const size_t hstep = (size_t)HALF * K * 2;
    const size_t tstep = 2 * hstep;
    const unsigned ldsw = (unsigned)wid * 1024u;
    const int aoff = lds_byte(wr * 64 + fr, fq * 8), boff = lds_byte(wc * 32 + fr, fq * 8);
#define PG8_SA(b, h) (((b) * 2 + (h)) * HTB)
#define PG8_SB(b, h) ((4 + (b) * 2 + (h)) * HTB)
#define PG8_STAGE(bufoff, gbase, voff) do { _Pragma("unroll") for (int _i = 0; _i < 2; ++_i) \
        __builtin_amdgcn_global_load_lds((const unsigned*)((const char*)(gbase) + (voff)[_i]), (PG8_LAS unsigned*)(lds + (bufoff) + ldsw + _i * 8192), 16, 0, 0); } while (0)
#define PG8_LDA(dst, b, h) do { _Pragma("unroll") for (int m = 0; m < 4; ++m) _Pragma("unroll") for (int k = 0; k < 2; ++k) dst[m][k] = *(const PG8_LAS bf16x8*)(lds + PG8_SA(b, h) + aoff + m * 2048 + k * 1024); } while (0)
#define PG8_LDB(dst, b, h) do { _Pragma("unroll") for (int n = 0; n < 2; ++n) _Pragma("unroll") for (int k = 0; k < 2; ++k) dst[n][k] = *(const PG8_LAS bf16x8*)(lds + PG8_SB(b, h) + boff + n * 2048 + k * 1024); } while (0)
#define PG8_MMA(ai, bj, At, Bt) do { __builtin_amdgcn_s_setprio(1); _Pragma("unroll") for (int m = 0; m < 4; ++m) _Pragma("unroll") for (int n = 0; n < 2; ++n) _Pragma("unroll") for (int k = 0; k < 2; ++k) \
        acc[ai][bj][m][n] = __builtin_amdgcn_mfma_f32_16x16x32_bf16(Bt[n][k], At[m][k], acc[ai][bj][m][n], 0, 0, 0); __builtin_amdgcn_s_setprio(0); } while (0)
#define PG8_WAIT_V(n) asm volatile("s_waitcnt vmcnt(" #n ")" ::: "memory")
#define PG8_WAIT_L(n) asm volatile("s_waitcnt lgkmcnt(" #n ")" ::: "memory")
#define PG8_BAR __builtin_amdgcn_s_barrier()
#define PG8_SCHED __builtin_amdgcn_sched_barrier(0)
    Unit cur, nxt; int ui = 0;
    if (!S.next(0, cur)) return;
    f32x4 acc[2][2][4][2];
#pragma unroll
    for (int a = 0; a < 2; ++a)
#pragma unroll
        for (int b = 0; b < 2; ++b)
#pragma unroll
            for (int m = 0; m < 4; ++m)
#pragma unroll
                for (int n = 0; n < 2; ++n) acc[a][b][m][n] = (f32x4){0.f, 0.f, 0.f, 0.f};
    bf16x8 At[4][2], B0[2][2], B1[2][2];
    const char* cA = (const char*)g.A + (size_t)cur.pm * tstep; const char* cB = (const char*)g.Bt + (size_t)cur.pn * tstep;
    S.a_ready(cur);
    if constexpr (SP2) {
        PG8_STAGE(PG8_SB(0, 0), cB, voffB); PG8_STAGE(PG8_SB(0, 1), cB + hstep, voffB); PG8_STAGE(PG8_SA(0, 0), cA, voffA); PG8_STAGE(PG8_SA(0, 1), cA + hstep, voffA);
        if (wr == 1) PG8_BAR;
        PG8_WAIT_V(2); PG8_BAR;
        PG8_STAGE(PG8_SB(1, 0), cB + kstep, voffB); PG8_STAGE(PG8_SA(1, 0), cA + kstep, voffA); PG8_STAGE(PG8_SB(1, 1), cB + hstep + kstep, voffB);
        PG8_WAIT_V(6); PG8_BAR;
    } else {
        PG8_STAGE(PG8_SB(0, 0), cB, voffB); PG8_STAGE(PG8_SA(0, 0), cA, voffA); PG8_STAGE(PG8_SB(0, 1), cB + hstep, voffB); PG8_STAGE(PG8_SA(0, 1), cA + hstep, voffA);
        if (wr == 1) PG8_BAR;
        PG8_WAIT_V(4); PG8_BAR;
        PG8_STAGE(PG8_SB(1, 0), cB + kstep, voffB); PG8_STAGE(PG8_SA(1, 0), cA + kstep, voffA); PG8_STAGE(PG8_SB(1, 1), cB + hstep + kstep, voffB);
        PG8_WAIT_V(6); PG8_BAR;
    }
    for (;;) {
        const bool has_next = S.next(ui + 1, nxt);
        const char* nA = has_next ? (const char*)g.A + (size_t)nxt.pm * tstep : cA; const char* nB = has_next ? (const char*)g.Bt + (size_t)nxt.pn * tstep : cB;
        for (int t = 0; t < nt; t += 2) {
            const bool last = (t == nt - 2);
            const char* a1 = cA + (size_t)(t + 1) * kstep;
            const char* a2 = last ? nA : cA + (size_t)(t + 2) * kstep; const char* b2 = last ? nB : cB + (size_t)(t + 2) * kstep;
            const char* a3 = a2 + kstep; const char* b3 = b2 + kstep;
            if (last && has_next) S.a_ready(nxt);
            if constexpr (SP2) {
            PG8_LDB(B0, 0, 0); PG8_LDB(B1, 0, 1); PG8_SCHED; PG8_LDA(At, 0, 0); PG8_STAGE(PG8_SA(1, 1), a1 + hstep, voffA);
            PG8_WAIT_V(8); PG8_WAIT_L(0); PG8_BAR; PG8_MMA(0, 0, At, B0); PG8_MMA(0, 1, At, B1); PG8_BAR; PG8_SCHED;
            PG8_LDA(At, 0, 1); PG8_STAGE(PG8_SB(0, 0), b2, voffB); PG8_STAGE(PG8_SB(0, 1), b2 + hstep, voffB); PG8_STAGE(PG8_SA(0, 0), a2, voffA);
            PG8_WAIT_V(8); PG8_WAIT_L(0); PG8_BAR; PG8_MMA(1, 0, At, B0); PG8_MMA(1, 1, At, B1); PG8_BAR; PG8_SCHED;
            PG8_LDB(B0, 1, 0); PG8_LDB(B1, 1, 1); PG8_SCHED; PG8_LDA(At, 1, 0); PG8_STAGE(PG8_SA(0, 1), a2 + hstep, voffA);
            PG8_WAIT_V(8); PG8_WAIT_L(0); PG8_BAR; PG8_MMA(0, 0, At, B0); PG8_MMA(0, 1, At, B1); PG8_BAR; PG8_SCHED;
            PG8_LDA(At, 1, 1); PG8_STAGE(PG8_SB(1, 0), b3, voffB); PG8_STAGE(PG8_SB(1, 1), b3 + hstep, voffB); PG8_STAGE(PG8_SA(1, 0), a3, voffA);
            PG8_WAIT_V(8); PG8_WAIT_L(0); PG8_BAR; PG8_MMA(1, 0, At, B0); PG8_MMA(1, 1, At, B1); PG8_BAR; PG8_SCHED;
            } else {
            PG8_LDB(B0, 0, 0); PG8_SCHED; PG8_LDA(At, 0, 0); PG8_STAGE(PG8_SA(1, 1), a1 + hstep, voffA);
            PG8_WAIT_L(8); PG8_BAR; PG8_WAIT_L(0); PG8_MMA(0, 0, At, B0); PG8_BAR; PG8_SCHED;
            PG8_LDB(B1, 0, 1); PG8_STAGE(PG8_SB(0, 0), b2, voffB);
            PG8_BAR; PG8_WAIT_L(0); PG8_MMA(0, 1, At, B1); PG8_BAR;
            PG8_LDA(At, 0, 1); PG8_STAGE(PG8_SA(0, 0), a2, voffA);
            PG8_BAR; PG8_WAIT_L(0); PG8_MMA(1, 0, At, B0); PG8_BAR; PG8_SCHED;
            PG8_STAGE(PG8_SB(0, 1), b2 + hstep, voffB);
            PG8_WAIT_V(6); PG8_BAR; PG8_MMA(1, 1, At, B1); PG8_BAR;
            PG8_LDB(B0, 1, 0); PG8_SCHED; PG8_LDA(At, 1, 0); PG8_STAGE(PG8_SA(0, 1), a2 + hstep, voffA);
            PG8_WAIT_L(8); PG8_BAR; PG8_WAIT_L(0); PG8_MMA(0, 0, At, B0); PG8_BAR; PG8_SCHED;
            PG8_LDB(B1, 1, 1); PG8_STAGE(PG8_SB(1, 0), b3, voffB);
            PG8_BAR; PG8_WAIT_L(0); PG8_MMA(0, 1, At, B1); PG8_BAR;
            PG8_LDA(At, 1, 1); PG8_STAGE(PG8_SA(1, 0), a3, voffA);
            PG8_BAR; PG8_WAIT_L(0); PG8_MMA(1, 0, At, B0); PG8_BAR; PG8_SCHED;
            PG8_STAGE(PG8_SB(1, 1), b3 + hstep, voffB);
            PG8_WAIT_V(6); PG8_BAR; PG8_MMA(1, 1, At, B1); PG8_BAR;
            }
        }
        if constexpr (ALIGN_EPI) { if (wr == 0) PG8_BAR; }
        if constexpr (!Epi::AFTER_DRAIN) { E(acc, cur, wr, wc, fr, fq); S.done(cur); }
        if (!has_next) break;
#pragma unroll
        for (int a = 0; a < 2; ++a)
#pragma unroll
            for (int b = 0; b < 2; ++b)
#pragma unroll
                for (int m = 0; m < 4; ++m)
#pragma unroll
                    for (int n = 0; n < 2; ++n) acc[a][b][m][n] = (f32x4){0.f, 0.f, 0.f, 0.f};
        cur = nxt; cA = nA; cB = nB; ++ui;
        if constexpr (ALIGN_EPI) { if (wr == 1) PG8_BAR; }
    }
    PG8_WAIT_V(0);
    if constexpr (!ALIGN_EPI) { if (wr == 0) PG8_BAR; }
    PG8_BAR;
    if constexpr (Epi::AFTER_DRAIN) { E.fused(acc, cur, wr, wc, fr, fq, lds, wid, lane); S.done(cur); }
#undef PG8_SA
#undef PG8_SB
#undef PG8_STAGE
#undef PG8_LDA
#undef PG8_LDB
#undef PG8_MMA
#undef PG8_WAIT_V
#undef PG8_WAIT_L
#undef PG8_BAR
#undef PG8_SCHED
}
}

using pg8::bf16_t; using pg8::bf16x8; using pg8::f32x4; using pg8::u32x4; using pg8::Unit;
constexpr int DM = 1024, NB = 16, SEQ = 4096, NMETA = 16, MREAL = NB * SEQ  , MTOK = MREAL + NB * NMETA  ;
constexpr int FF = 2816, NH = 16, HD = 64;
constexpr float EPS = 1e-6f, LOG2E = 1.4426950408889634f;

constexpr size_t MiB = 1u << 20;
constexpr size_t WS_ROPE = 512 * 1024;
constexpr size_t WS_SSQ = 1 * MiB;
constexpr size_t WS_RMS = 6 * MiB;
constexpr size_t WS_W = 8 * MiB;
constexpr size_t W_GU_BYTES = (size_t)2 * FF * DM * 2, W_DN_BYTES = (size_t)DM * FF * 2, W_FFN_BYTES = W_GU_BYTES + W_DN_BYTES;
constexpr size_t W_NA = 4 * W_FFN_BYTES, W_NA_QK = W_NA, W_NA_V = W_NA + (size_t)2048 * DM * 2, W_NA_O = W_NA_V + (size_t)DM * DM * 2;
constexpr size_t W_GQA = W_NA_O + (size_t)DM * DM * 2, W_GQA_QK = W_GQA, W_GQA_V = W_GQA + (size_t)1280 * DM * 2, W_GQA_O = W_GQA_V + (size_t)256 * DM * 2;
constexpr size_t W_END = W_GQA_O + (size_t)DM * DM * 2;
static_assert(W_END <= 88 * MiB, "weights region");
constexpr size_t WS_H = 96 * MiB;
constexpr size_t WS_XN = 353 * MiB;
constexpr size_t WS_Y = 482 * MiB;
constexpr size_t WS_BIG = 611 * MiB;
constexpr size_t WS_VT = WS_BIG + (size_t)MTOK * 2048 * 2;
constexpr size_t WS_END = WS_VT + (size_t)DM * MTOK * 2;
static_assert(WS_END <= 1024 * MiB && WS_BIG + (size_t)MTOK * FF * 2 <= 1024 * MiB, "workspace");
static_assert(WS_H + (size_t)MTOK * DM * 4 <= WS_XN && WS_XN + (size_t)MTOK * DM * 2 <= WS_Y && WS_Y + (size_t)MTOK * DM * 2 <= WS_BIG, "workspace map");

constexpr int LDS_BYTES = 135168;
constexpr int NTHREADS = 512;

struct Params { const float* in[14]; float* out; unsigned char* ws; int ph_lo, ph_hi; };

typedef float f32x2_t __attribute__((ext_vector_type(2)));
typedef __bf16 bf16x2_t __attribute__((ext_vector_type(2)));
__device__ __forceinline__ unsigned pk2(float lo, float hi) { const f32x2_t v = {lo, hi}; const bf16x2_t b = __builtin_convertvector(v, bf16x2_t); return __builtin_bit_cast(unsigned, b); }
__device__ __forceinline__ float bf_lo(unsigned w) { return __uint_as_float(w << 16); }
__device__ __forceinline__ float bf_hi(unsigned w) { return __uint_as_float(w & 0xffff0000u); }
__device__ __forceinline__ float wave_sum(float v) {
#pragma unroll
    for (int o = 32; o >= 1; o >>= 1) v += __shfl_xor(v, o);
    return v;
}

struct EpiSwiGLU {
    static constexpr bool PERM = true, AFTER_DRAIN = false;
    bf16_t* O;
    __device__ __forceinline__ void operator()(const f32x4 (&acc)[2][2][4][2], const Unit& u, int wr, int wc, int fr, int fq) const {
        const int row0 = u.pm * 256 + wr * 64 + fr, col0 = u.pn * 128 + wc * 32 + 8 * fq;
#pragma unroll
        for (int ai = 0; ai < 2; ++ai)
#pragma unroll
            for (int m = 0; m < 4; ++m) {
                bf16_t* p = O + (size_t)(row0 + ai * 128 + m * 16) * FF + col0;
                float h[8];
#pragma unroll
                for (int n = 0; n < 2; ++n)
#pragma unroll
                    for (int e = 0; e < 4; ++e) { const float gneg = acc[ai][0][m][n][e], ups = acc[ai][1][m][n][e];
                        h[n * 4 + e] = gneg * ups * __builtin_amdgcn_rcpf(1.0f + __builtin_amdgcn_exp2f(gneg)); }
                u32x4 w; w.x = pk2(h[0], h[1]); w.y = pk2(h[2], h[3]); w.z = pk2(h[4], h[5]); w.w = pk2(h[6], h[7]);
                *(u32x4*)p = w;
            }
    }
};
struct EpiY {
    static constexpr bool PERM = true, AFTER_DRAIN = false;
    bf16_t* Y; float* ssqp;
    __device__ __forceinline__ void operator()(const f32x4 (&acc)[2][2][4][2], const Unit& u, int wr, int wc, int fr, int fq) const {
        const int row0 = u.pm * 256 + wr * 64 + fr, col0 = u.pn * 256 + wc * 32 + 8 * fq;
#pragma unroll
        for (int ai = 0; ai < 2; ++ai)
#pragma unroll
            for (int m = 0; m < 4; ++m) {
                const int row = row0 + ai * 128 + m * 16; float s = 0.f;
#pragma unroll
                for (int bj = 0; bj < 2; ++bj) { const f32x4 v0 = acc[ai][bj][m][0], v1 = acc[ai][bj][m][1];
                    s += (v0[0] * v0[0] + v0[1] * v0[1]) + (v0[2] * v0[2] + v0[3] * v0[3]) + (v1[0] * v1[0] + v1[1] * v1[1]) + (v1[2] * v1[2] + v1[3] * v1[3]);
                    u32x4 w; w.x = pk2(v0[0], v0[1]); w.y = pk2(v0[2], v0[3]); w.z = pk2(v1[0], v1[1]); w.w = pk2(v1[2], v1[3]);
                    *(u32x4*)(Y + (size_t)row * DM + col0 + bj * 128) = w; }
                s += __shfl_xor(s, 16); s += __shfl_xor(s, 32);
                if (fq == 0) ssqp[(size_t)row * 16 + u.pn * 4 + wc] = s;
            }
    }
};
struct EpiPlain {
    static constexpr bool PERM = true, AFTER_DRAIN = false;
    bf16_t* O; size_t ldc;
    __device__ __forceinline__ void operator()(const f32x4 (&acc)[2][2][4][2], const Unit& u, int wr, int wc, int fr, int fq) const {
        const int row0 = u.pm * 256 + wr * 64 + fr, col0 = u.pn * 256 + wc * 32 + 8 * fq;
#pragma unroll
        for (int ai = 0; ai < 2; ++ai)
#pragma unroll
            for (int m = 0; m < 4; ++m)
#pragma unroll
                for (int bj = 0; bj < 2; ++bj) { const f32x4 v0 = acc[ai][bj][m][0], v1 = acc[ai][bj][m][1];
                    u32x4 w; w.x = pk2(v0[0], v0[1]); w.y = pk2(v0[2], v0[3]); w.z = pk2(v1[0], v1[1]); w.w = pk2(v1[2], v1[3]);
                    *(u32x4*)(O + (size_t)(row0 + ai * 128 + m * 16) * ldc + col0 + bj * 128) = w; }
    }
};
template <bool GQA> struct EpiQK {
    static constexpr bool PERM = true, AFTER_DRAIN = false;
    bf16_t* O; int ldo; float qscale; const float* qgain; const float* kgain; const float* ropec; const float* ropes;
    __device__ __forceinline__ void operator()(const f32x4 (&acc)[2][2][4][2], const Unit& u, int wr, int wc, int fr, int fq) const {
        const bool isq = u.pn < 4; const float sc = isq ? qscale : 1.0f;
        const int colb = 64 * (4 * u.pn + wc) + 8 * fq;
        f32x4 gn[2][2];
        if (GQA) { const float* gp = isq ? qgain : kgain;
#pragma unroll
            for (int bj = 0; bj < 2; ++bj)
#pragma unroll
                for (int n = 0; n < 2; ++n) gn[bj][n] = *(const f32x4*)(gp + 32 * bj + 16 * n + 4 * fq); }
#pragma unroll
        for (int ai = 0; ai < 2; ++ai)
#pragma unroll
            for (int m = 0; m < 4; ++m) {
                const int row = u.pm * 256 + ai * 128 + wr * 64 + m * 16 + fr;
                f32x4 x[2][2];
#pragma unroll
                for (int bj = 0; bj < 2; ++bj)
#pragma unroll
                    for (int n = 0; n < 2; ++n) x[bj][n] = acc[ai][bj][m][n];
                if (GQA) {
                    float s = 0.f;
#pragma unroll
                    for (int bj = 0; bj < 2; ++bj)
#pragma unroll
                        for (int n = 0; n < 2; ++n) s += (x[bj][n][0] * x[bj][n][0] + x[bj][n][1] * x[bj][n][1]) + (x[bj][n][2] * x[bj][n][2] + x[bj][n][3] * x[bj][n][3]);
                    s += __shfl_xor(s, 16); s += __shfl_xor(s, 32);
                    const float rstd = rsqrtf(s * (1.0f / 64.0f) + EPS);
#pragma unroll
                    for (int bj = 0; bj < 2; ++bj)
#pragma unroll
                        for (int n = 0; n < 2; ++n) x[bj][n] = x[bj][n] * rstd * gn[bj][n];
                    if (u.pm < 256) {
                        const int sidx = row & 4095; const int pos[2] = {sidx >> 6, sidx & 63};
#pragma unroll
                        for (int bj = 0; bj < 2; ++bj) {
                            const f32x4 c = *(const f32x4*)(ropec + pos[bj] * 16 + 4 * fq), sn = *(const f32x4*)(ropes + pos[bj] * 16 + 4 * fq);
                            const f32x4 x1 = x[bj][0], x2 = x[bj][1];
                            x[bj][0] = x1 * c - x2 * sn; x[bj][1] = x2 * c + x1 * sn;
                        }
                    }
                }
#pragma unroll
                for (int bj = 0; bj < 2; ++bj) { const f32x4 v0 = x[bj][0] * sc, v1 = x[bj][1] * sc;
                    u32x4 w; w.x = pk2(v0[0], v0[1]); w.y = pk2(v0[2], v0[3]); w.z = pk2(v1[0], v1[1]); w.w = pk2(v1[2], v1[3]);
                    *(u32x4*)(O + (size_t)row * ldo + colb + 32 * bj) = w; }
            }
    }
};


__device__ __forceinline__ void meta_gemm_y(const bf16_t* A, const bf16_t* Wt, const int K, bf16_t* Y, float* ssqp, unsigned char* smem, const int tid) {
    const int wave = tid >> 6, lane = tid & 63, fr = lane & 15, fq = lane >> 4;
    float* red = (float*)smem;
    const int kw = K >> 3;
    for (int su = blockIdx.x; su < 256; su += gridDim.x) {
        const int rt = su >> 4, ct = su & 15;
        const bf16_t* ap = A + (size_t)(MREAL + 16 * rt + fr) * K + wave * kw + 8 * fq;
        const bf16_t* bp = Wt + (size_t)(64 * ct + fr) * K + wave * kw + 8 * fq;
        f32x4 acc[4];
#pragma unroll
        for (int c4 = 0; c4 < 4; ++c4) acc[c4] = (f32x4){0.f, 0.f, 0.f, 0.f};
#pragma unroll 4
        for (int k = 0; k < kw; k += 32) {
            const bf16x8 a = *(const bf16x8*)(ap + k);
#pragma unroll
            for (int c4 = 0; c4 < 4; ++c4) acc[c4] = __builtin_amdgcn_mfma_f32_16x16x32_bf16(a, *(const bf16x8*)(bp + (size_t)(16 * c4) * K + k), acc[c4], 0, 0, 0);
        }
#pragma unroll
        for (int c4 = 0; c4 < 4; ++c4)
#pragma unroll
            for (int i = 0; i < 4; ++i) red[(wave * 16 + 4 * fq + i) * 64 + 16 * c4 + fr] = acc[c4][i];
        __syncthreads();
        const int row = 2 * wave + (lane >> 5), cp = lane & 31;
        float s0 = 0.f, s1 = 0.f;
#pragma unroll
        for (int w = 0; w < 8; ++w) { const f32x2_t v = *(const f32x2_t*)(red + (w * 16 + row) * 64 + 2 * cp); s0 += v.x; s1 += v.y; }
        const int grow = MREAL + 16 * rt + row;
        *(unsigned*)(Y + (size_t)grow * DM + 64 * ct + 2 * cp) = pk2(s0, s1);
        float q = s0 * s0 + s1 * s1;
        q += __shfl_xor(q, 1); q += __shfl_xor(q, 2); q += __shfl_xor(q, 4); q += __shfl_xor(q, 8); q += __shfl_xor(q, 16);
        if (cp == 0) ssqp[(size_t)grow * 16 + ct] = q;
        __syncthreads();
    }
}

__device__ __forceinline__ void p0_weights(const Params& P, unsigned char* smem, const int tid) {
    float* tile = (float*)smem;
    unsigned char* W = P.ws + WS_W;
    for (int job = 0; job < 14; ++job) {
        const float* srcA; const float* srcB = nullptr; int ld, N, K, kind, coloff = 0; bf16_t* dst;
        const float* gk = nullptr;
        if (job < 8) { const int lj = job >> 1, dn = job & 1;
            if (!dn) gk = P.in[2] + (size_t)((lj >> 1) * 6 + ((lj & 1) ? 4 : 0)) * DM;
            if (!dn) { kind = 0; srcA = P.in[3] + (size_t)lj * DM * FF; srcB = P.in[4] + (size_t)lj * DM * FF; ld = FF; N = 2 * FF; K = DM; dst = (bf16_t*)(W + lj * W_FFN_BYTES); }
            else     { kind = 1; srcA = P.in[5] + (size_t)lj * FF * DM; ld = DM; N = DM; K = FF; dst = (bf16_t*)(W + lj * W_FFN_BYTES + W_GU_BYTES); } }
        else if (job == 8)  { gk = P.in[2] + (size_t)(0 * 6 + 2) * DM; kind = 2; srcA = P.in[6];  ld = 3072; N = 2048; K = DM; dst = (bf16_t*)(W + W_NA_QK); }
        else if (job == 9)  { gk = P.in[2] + (size_t)(0 * 6 + 2) * DM; kind = 1; srcA = P.in[6];  ld = 3072; N = 1024; K = DM; coloff = 2048; dst = (bf16_t*)(W + W_NA_V); }
        else if (job == 10) { kind = 1; srcA = P.in[7];  ld = 1024; N = 1024; K = DM; dst = (bf16_t*)(W + W_NA_O); }
        else if (job == 11) { gk = P.in[2] + (size_t)(1 * 6 + 2) * DM; kind = 3; srcA = P.in[10]; ld = 1536; N = 1280; K = DM; dst = (bf16_t*)(W + W_GQA_QK); }
        else if (job == 12) { gk = P.in[2] + (size_t)(1 * 6 + 2) * DM; kind = 1; srcA = P.in[10]; ld = 1536; N = 256;  K = DM; coloff = 1280; dst = (bf16_t*)(W + W_GQA_V); }
        else                { kind = 1; srcA = P.in[11]; ld = 1024; N = 1024; K = DM; dst = (bf16_t*)(W + W_GQA_O); }
        const int ntn = N / 64, ntk = K / 64;
        for (int t = blockIdx.x; t < ntn * ntk; t += gridDim.x) {
            const int n0 = (t % ntn) * 64, k0 = (t / ntn) * 64;
            const int nn = tid & 63, p = n0 + nn;
            const float* cp;
            if (kind == 0) { const int bj = (p >> 7) & 1, col = (p >> 8) * 128 + (p & 127); cp = (bj ? srcB : srcA) + col; }
            else if (kind == 1) cp = srcA + coloff + p;
            else { const int c32 = p & 31, wcw = (p >> 5) & 3, bj = (p >> 7) & 1, pn = p >> 8;
                const int d = (kind == 2) ? (32 * bj + c32) : (32 * bj + 16 * ((c32 >> 2) & 1) + 4 * (c32 >> 3) + (c32 & 3));
                cp = srcA + 64 * (4 * pn + wcw) + d; }
            const float wsc = (kind == 0) ? ((((n0 + nn) >> 7) & 1) ? -0.6931471805599453f : -LOG2E) : 1.0f;
#pragma unroll
            for (int i = 0; i < 8; ++i) { const int kk = (tid >> 6) + 8 * i; tile[kk * 65 + nn] = cp[(size_t)(k0 + kk) * ld] * wsc * (gk ? gk[k0 + kk] : 1.0f); }
            __syncthreads();
            const int nn2 = tid >> 3, ks = (tid & 7) * 8;
            float v[8];
#pragma unroll
            for (int e = 0; e < 8; ++e) v[e] = tile[(ks + e) * 65 + nn2];
            u32x4 w; w.x = pk2(v[0], v[1]); w.y = pk2(v[2], v[3]); w.z = pk2(v[4], v[5]); w.w = pk2(v[6], v[7]);
            *(u32x4*)(dst + (size_t)(n0 + nn2) * K + k0 + ks) = w;
            __syncthreads();
        }
    }
    for (int i = blockIdx.x * NTHREADS + tid; i < 1024; i += gridDim.x * NTHREADS) {
        const int pos = i >> 4, f = i & 15;
        const float freq = __builtin_amdgcn_exp2f(-(float)f * (13.287712379549449f / 16.0f));
        const float ang = (float)pos * freq;
        const float kq = rintf(ang * 0.15915494309189535f);
        float r = fmaf(-kq, 6.28318548202514648f, ang); r = fmaf(-kq, -1.74845553e-07f, r);
        ((float*)(P.ws + WS_ROPE))[i] = __cosf(r); ((float*)(P.ws + WS_ROPE))[1024 + i] = __sinf(r);
    }
}

typedef unsigned u32x2 __attribute__((ext_vector_type(2)));
struct NrRow { f32x4 h[4]; u32x2 y[4]; float ss, rms; };
__device__ __forceinline__ void nr_load(NrRow& R, const Params& P, int row, bool src_input, bool has_y, const bf16_t* h, const bf16_t* y, const float* ssqp, int lane) {
    if (src_input) {
        const float* hs = row < MREAL ? P.in[0] + (size_t)row * DM : P.in[1] + (size_t)((row - MREAL) & 15) * DM;
#pragma unroll
        for (int j = 0; j < 4; ++j) R.h[j] = *(const f32x4*)(hs + 4 * lane + 256 * j);
    } else {
#pragma unroll
        for (int j = 0; j < 4; ++j) { const u32x2 w = __builtin_nontemporal_load((const u32x2*)(h + (size_t)row * DM + 4 * lane + 256 * j)); R.h[j] = (f32x4){bf_lo(w.x), bf_hi(w.x), bf_lo(w.y), bf_hi(w.y)}; }
        R.rms = ((const float*)(P.ws + WS_RMS))[row];
    }
    if (has_y) {
#pragma unroll
        for (int j = 0; j < 4; ++j) R.y[j] = __builtin_nontemporal_load((const u32x2*)(y + (size_t)row * DM + 4 * lane + 256 * j));
        R.ss = ssqp[(size_t)row * 16 + (lane & 15)];
    }
}
__device__ __forceinline__ void nr_phase(const Params& P, bool src_input, bool has_y, bool write_h, bool final_out, float coef, const float* gpost, const float* gpre, const int tid) {
    const int wave = tid >> 6, lane = tid & 63;
    bf16_t* xn = (bf16_t*)(P.ws + WS_XN); bf16_t* h = xn; const bf16_t* y = (const bf16_t*)(P.ws + WS_Y); const float* ssqp = (const float*)(P.ws + WS_SSQ); float* rmsb = (float*)(P.ws + WS_RMS);
    f32x4 gp[4];
#pragma unroll
    for (int j = 0; j < 4; ++j) gp[j] = *(const f32x4*)(gpost + 4 * lane + 256 * j);
    const int stride = gridDim.x * 8;
    int row = blockIdx.x * 8 + wave;
    NrRow nx, nx2;
    if (row < MTOK) nr_load(nx, P, row, src_input, has_y, h, y, ssqp, lane);
    if (row + stride < MTOK) nr_load(nx2, P, row + stride, src_input, has_y, h, y, ssqp, lane);
    for (; row < MTOK; row += stride) {
        NrRow cu = nx; nx = nx2;
        if (row + 2 * stride < MTOK) nr_load(nx2, P, row + 2 * stride, src_input, has_y, h, y, ssqp, lane);
        f32x4 v[4];
#pragma unroll
        for (int j = 0; j < 4; ++j) v[j] = src_input ? cu.h[j] : cu.h[j] * cu.rms;
        if (has_y) {
            float ss = cu.ss; ss += __shfl_xor(ss, 1); ss += __shfl_xor(ss, 2); ss += __shfl_xor(ss, 4); ss += __shfl_xor(ss, 8);
            const float sc = coef * rsqrtf(ss * (1.0f / DM) + EPS);
#pragma unroll
            for (int j = 0; j < 4; ++j) v[j] += (f32x4){bf_lo(cu.y[j].x), bf_hi(cu.y[j].x), bf_lo(cu.y[j].y), bf_hi(cu.y[j].y)} * gp[j] * sc;
        }
        if (final_out) {
            if (row < MREAL) { float* o = P.out + (size_t)row * DM;
#pragma unroll
                for (int j = 0; j < 4; ++j) *(f32x4*)(o + 4 * lane + 256 * j) = v[j]; }
            continue;
        }
        float s2 = 0.f;
#pragma unroll
        for (int j = 0; j < 4; ++j) s2 += (v[j][0] * v[j][0] + v[j][1] * v[j][1]) + (v[j][2] * v[j][2] + v[j][3] * v[j][3]);
        s2 = wave_sum(s2);
        const float ms = s2 * (1.0f / DM) + EPS, r2 = rsqrtf(ms);
        if (lane == 0) rmsb[row] = ms * r2;
#pragma unroll
        for (int j = 0; j < 4; ++j) { const f32x4 a = v[j] * r2; u32x2 w; w.x = pk2(a[0], a[1]); w.y = pk2(a[2], a[3]);
            *(u32x2*)(xn + (size_t)row * DM + 4 * lane + 256 * j) = w; }
    }
}

struct NaiveState { float m, l; float o[64]; };
__device__ __forceinline__ void naive_key(NaiveState& st, const float (&q)[64], const bf16_t* krow, const bf16_t* vcol  , float bias2) {
    float s = bias2;
#pragma unroll
    for (int c = 0; c < 8; ++c) { const u32x4 kw = *(const u32x4*)(krow + 8 * c);
        s += q[8 * c + 0] * bf_lo(kw.x) + q[8 * c + 1] * bf_hi(kw.x) + q[8 * c + 2] * bf_lo(kw.y) + q[8 * c + 3] * bf_hi(kw.y)
           + q[8 * c + 4] * bf_lo(kw.z) + q[8 * c + 5] * bf_hi(kw.z) + q[8 * c + 6] * bf_lo(kw.w) + q[8 * c + 7] * bf_hi(kw.w); }
    const float mn = fmaxf(st.m, s), corr = __builtin_amdgcn_exp2f(st.m - mn), p = __builtin_amdgcn_exp2f(s - mn);
    st.m = mn; st.l = st.l * corr + p;
#pragma unroll
    for (int d = 0; d < 64; ++d) st.o[d] = st.o[d] * corr + p * __uint_as_float((unsigned)vcol[(size_t)d * MTOK] << 16);
}
__device__ __forceinline__ void naive_load_q(float (&q)[64], const bf16_t* qp) {
#pragma unroll
    for (int c = 0; c < 8; ++c) { const u32x4 w = *(const u32x4*)(qp + 8 * c);
        q[8 * c + 0] = bf_lo(w.x); q[8 * c + 1] = bf_hi(w.x); q[8 * c + 2] = bf_lo(w.y); q[8 * c + 3] = bf_hi(w.y);
        q[8 * c + 4] = bf_lo(w.z); q[8 * c + 5] = bf_hi(w.z); q[8 * c + 6] = bf_lo(w.w); q[8 * c + 7] = bf_hi(w.w); }
}
__device__ __forceinline__ void naive_store_o(const NaiveState& st, bf16_t* op) {
    const float inv = 1.0f / st.l;
#pragma unroll
    for (int c = 0; c < 8; ++c) { u32x4 w; w.x = pk2(st.o[8 * c] * inv, st.o[8 * c + 1] * inv); w.y = pk2(st.o[8 * c + 2] * inv, st.o[8 * c + 3] * inv);
        w.z = pk2(st.o[8 * c + 4] * inv, st.o[8 * c + 5] * inv); w.w = pk2(st.o[8 * c + 6] * inv, st.o[8 * c + 7] * inv); *(u32x4*)(op + 8 * c) = w; }
}
__device__ __forceinline__ void na_attn_naive(const Params& P, const int tid) {
    const bf16_t* qk = (const bf16_t*)(P.ws + WS_BIG); const bf16_t* vt = (const bf16_t*)(P.ws + WS_VT); bf16_t* o = (bf16_t*)(P.ws + WS_H);
    const float* rpb = P.in[8]; const float* mbias = P.in[9];
    const int wave = tid >> 6, lane = tid & 63;
    for (int u = blockIdx.x * 8 + wave; u < 16384 + 256; u += gridDim.x * 8) {
        const bool meta = u >= 16384;
        int b, hd, r;
        if (!meta) { hd = u & 15; r = (u >> 4) & 63; b = u >> 10; } else { const int t = u - 16384; hd = t & 15; b = t >> 4; r = 0; }
        if (meta && lane >= 16) continue;
        const int c = lane;
        const int qrow = meta ? MREAL + b * 16 + lane : b * 4096 + r * 64 + c;
        float q[64]; naive_load_q(q, qk + (size_t)qrow * 2048 + hd * 64);
        NaiveState st; st.m = -1e30f; st.l = 0.f;
#pragma unroll
        for (int d = 0; d < 64; ++d) st.o[d] = 0.f;
        const bf16_t* vh = vt + (size_t)(hd * 64) * MTOK;
        for (int j = 0; j < 16; ++j) { const int krow = MREAL + b * 16 + j;
            naive_key(st, q, qk + (size_t)krow * 2048 + 1024 + hd * 64, vh + krow, meta ? 0.f : mbias[hd * 16 + j] * LOG2E); }
        if (!meta) {
            const int rs = min(max(r - 4, 0), 56), cs = min(max(c - 8, 0), 48);
            for (int i = 0; i < 8; ++i)
                for (int j = 0; j < 16; ++j) { const int krow = b * 4096 + (rs + i) * 64 + cs + j;
                    const float bias = rpb[(hd * 15 + (rs + i - r + 7)) * 31 + (cs + j - c + 15)];
                    naive_key(st, q, qk + (size_t)krow * 2048 + 1024 + hd * 64, vh + krow, bias * LOG2E); }
        }
        naive_store_o(st, o + (size_t)qrow * DM + hd * 64);
    }
}
__device__ __forceinline__ void gqa_attn_naive(const Params& P, const int tid) {
    const bf16_t* qk = (const bf16_t*)(P.ws + WS_BIG); const bf16_t* vt = (const bf16_t*)(P.ws + WS_VT); bf16_t* o = (bf16_t*)(P.ws + WS_H);
    const int wave = tid >> 6, lane = tid & 63;
    for (int u = blockIdx.x * 8 + wave; u < 16384 + 256; u += gridDim.x * 8) {
        const bool meta = u >= 16384;
        int b, hd, qb;
        if (!meta) { qb = u & 63; hd = (u >> 6) & 15; b = u >> 10; } else { const int t = u - 16384; hd = t & 15; b = t >> 4; qb = 0; }
        if (meta && lane >= 16) continue;
        const int kvh = hd >> 2;
        const int qrow = meta ? MREAL + b * 16 + lane : b * 4096 + qb * 64 + lane;
        float q[64]; naive_load_q(q, qk + (size_t)qrow * 1280 + hd * 64);
        NaiveState st; st.m = -1e30f; st.l = 0.f;
#pragma unroll
        for (int d = 0; d < 64; ++d) st.o[d] = 0.f;
        const bf16_t* vh = vt + (size_t)(kvh * 64) * MTOK;
        for (int j = 0; j < 4096 + 16; ++j) { const int krow = j < 4096 ? b * 4096 + j : MREAL + b * 16 + (j - 4096);
            naive_key(st, q, qk + (size_t)krow * 1280 + 1024 + kvh * 64, vh + krow, 0.f); }
        naive_store_o(st, o + (size_t)qrow * DM + hd * 64);
    }
}


typedef float f32x16 __attribute__((ext_vector_type(16)));
constexpr int ATT_ROWB = 144, ATT_KB = 64 * ATT_ROWB, ATT_BUF = 2 * ATT_KB;
template <bool FIXEDM> __device__ __forceinline__ void gqa_attn_fast(const Params& P, unsigned char* smem, const int tid, const float bnd) {
    const bf16_t* qk = (const bf16_t*)(P.ws + WS_BIG); const bf16_t* vt = (const bf16_t*)(P.ws + WS_VT); bf16_t* o = (bf16_t*)(P.ws + WS_H);
    const int wave = tid >> 6, lane = tid & 63, r = lane & 31, h = lane >> 5, qsub = wave & 3, hp = wave >> 2;
    const int G = gridDim.x, bx = blockIdx.x;
    const int skey = tid >> 3, sch = tid & 7;
    const int kapr = (r & ~12) | ((r & 4) << 1) | ((r & 8) >> 1);
    const u32x4 zero4 = {0u, 0u, 0u, 0u};
    for (int it = 0;; ++it) {
        const int ulin = it * G + bx;
        if (ulin >= 2048 + 64) break;
        const bool meta = ulin >= 2048;
        int bk, qb;
        if (meta) { bk = ulin - 2048; qb = 0; }
        else if (G == 256) { bk = it * 8 + (bx & 7); qb = bx >> 3; }
        else { bk = ulin >> 5; qb = ulin & 31; }
        const int b = bk >> 2, kvh = bk & 3;
        const int ftile = meta ? qsub : 0;
        const int qrow = meta ? MREAL + b * 16 + (r & 15) : b * 4096 + qb * 128 + qsub * 32 + r;
        bf16x8 qf[2][4];
#pragma unroll
        for (int t = 0; t < 2; ++t)
#pragma unroll
            for (int s = 0; s < 4; ++s) qf[t][s] = *(const bf16x8*)(qk + (size_t)qrow * 1280 + (kvh * 4 + hp * 2 + t) * 64 + 16 * s + 8 * h);
        f32x16 O[2][2], negm[2], L; float l[2];
        const unsigned on0 = (r < 16) ? 0x3f803f80u : 0u, on1 = (r < 16) ? 0u : 0x3f803f80u;
        const u32x4 a0_u = {on0, on0, on0, on0}, a1_u = {on1, on1, on1, on1}; const bf16x8 onesA[2] = {__builtin_bit_cast(bf16x8, a0_u), __builtin_bit_cast(bf16x8, a1_u)};
#pragma unroll
        for (int t = 0; t < 2; ++t) { l[t] = 0.f;
#pragma unroll
            for (int i = 0; i < 16; ++i) { negm[t][i] = FIXEDM ? -bnd : 0.f; L[i] = 0.f; }
#pragma unroll
            for (int dt = 0; dt < 2; ++dt)
#pragma unroll
                for (int i = 0; i < 16; ++i) O[t][dt][i] = 0.f; }
        const bf16_t* kbase = qk + 1024 + kvh * 64 + sch * 8;
        const bf16_t* vbase = vt + (size_t)(kvh * 64 + skey) * MTOK + sch * 8;
        u32x4 kr, vr;
        { const int krow0 = b * 4096;
          kr = *(const u32x4*)(kbase + (size_t)(krow0 + skey) * 1280); vr = *(const u32x4*)(vbase + krow0);
          *(u32x4*)(smem + skey * ATT_ROWB + sch * 16) = kr; *(u32x4*)(smem + ATT_KB + skey * ATT_ROWB + sch * 16) = vr; }
        __syncthreads();
        for (int tile = 0; tile <= 64; ++tile) {
            const int buf = tile & 1;
            if (tile < 64) {
                const int nt = tile + 1;
                if (nt < 64) { const int krow0 = b * 4096 + nt * 64; kr = *(const u32x4*)(kbase + (size_t)(krow0 + skey) * 1280); vr = *(const u32x4*)(vbase + krow0); }
                else { const int krow0 = MREAL + b * 16;
                    kr = skey < 16 ? *(const u32x4*)(kbase + (size_t)(krow0 + skey) * 1280) : zero4;
                    vr = sch < 2 ? *(const u32x4*)(vbase + krow0) : zero4; }
            }
            if (!meta || (tile & 3) == qsub) {
                const unsigned char* Kb = smem + buf * ATT_BUF; const unsigned char* Vb = Kb + ATT_KB;
                if (FIXEDM && tile < 64) {
#pragma unroll
                for (int sub = 0; sub < 2; ++sub) {
                    bf16x8 kf[4], vf[2][2];
#pragma unroll
                    for (int s = 0; s < 4; ++s) kf[s] = *(const bf16x8*)(Kb + (sub * 32 + kapr) * ATT_ROWB + (16 * s + 8 * h) * 2);
#pragma unroll
                    for (int dt = 0; dt < 2; ++dt)
#pragma unroll
                        for (int s2 = 0; s2 < 2; ++s2) vf[dt][s2] = *(const bf16x8*)(Vb + (dt * 32 + r) * ATT_ROWB + (sub * 32 + 16 * s2 + 8 * h) * 2);
#pragma unroll
                    for (int t = 0; t < 2; ++t) {
                        f32x16 S = __builtin_amdgcn_mfma_f32_32x32x16_bf16(kf[0], qf[t][0], negm[FIXEDM ? 0 : t], 0, 0, 0);
#pragma unroll
                        for (int s = 1; s < 4; ++s) S = __builtin_amdgcn_mfma_f32_32x32x16_bf16(kf[s], qf[t][s], S, 0, 0, 0);
                        if (tile == 64) {
#pragma unroll
                            for (int i = 8; i < 16; ++i) S[i] = -1e30f;
                        }
                        if (!FIXEDM) {
                        float mx = fmaxf(fmaxf(S[0], S[1]), S[2]);
#pragma unroll
                        for (int i = 3; i < 15; i += 2) mx = fmaxf(fmaxf(mx, S[i]), S[i + 1]);
                        mx = fmaxf(mx, S[15]);
                        mx = fmaxf(mx, __shfl_xor(mx, 32));
                        const bool first = (tile == ftile) && (sub == 0);
                        if (first || __ballot(mx > 8.0f) != 0ull) {
                            const float d = first ? mx : fmaxf(mx, 0.f), alpha = first ? 1.0f : __builtin_amdgcn_exp2f(-d);
#pragma unroll
                            for (int i = 0; i < 16; ++i) { S[i] -= d; negm[t][i] -= d; }
#pragma unroll
                            for (int i = 0; i < 8; ++i) L[8 * t + i] *= alpha;
#pragma unroll
                            for (int dt = 0; dt < 2; ++dt)
#pragma unroll
                                for (int i = 0; i < 16; ++i) O[t][dt][i] *= alpha;
                        }
                        }
#pragma unroll
                        for (int i = 0; i < 16; ++i) S[i] = __builtin_amdgcn_exp2f(S[i]);
                        bf16x8 pf[2];
#pragma unroll
                        for (int s2 = 0; s2 < 2; ++s2) { u32x4 w; w.x = pk2(S[8 * s2], S[8 * s2 + 1]); w.y = pk2(S[8 * s2 + 2], S[8 * s2 + 3]);
                            w.z = pk2(S[8 * s2 + 4], S[8 * s2 + 5]); w.w = pk2(S[8 * s2 + 6], S[8 * s2 + 7]); pf[s2] = __builtin_bit_cast(bf16x8, w); }
#pragma unroll
                        for (int dt = 0; dt < 2; ++dt)
#pragma unroll
                            for (int s2 = 0; s2 < 2; ++s2) O[t][dt] = __builtin_amdgcn_mfma_f32_32x32x16_bf16(vf[dt][s2], pf[s2], O[t][dt], 0, 0, 0);
                        L = __builtin_amdgcn_mfma_f32_32x32x16_bf16(onesA[t], pf[0], L, 0, 0, 0);
                        L = __builtin_amdgcn_mfma_f32_32x32x16_bf16(onesA[t], pf[1], L, 0, 0, 0);
                    }
                }
                } else {
                const int nsub = tile < 64 ? 2 : 1;
#pragma unroll 1
                for (int sub = 0; sub < nsub; ++sub) {
                    bf16x8 kf[4], vf[2][2];
#pragma unroll
                    for (int s = 0; s < 4; ++s) kf[s] = *(const bf16x8*)(Kb + (sub * 32 + kapr) * ATT_ROWB + (16 * s + 8 * h) * 2);
#pragma unroll
                    for (int dt = 0; dt < 2; ++dt)
#pragma unroll
                        for (int s2 = 0; s2 < 2; ++s2) vf[dt][s2] = *(const bf16x8*)(Vb + (dt * 32 + r) * ATT_ROWB + (sub * 32 + 16 * s2 + 8 * h) * 2);
#pragma unroll
                    for (int t = 0; t < 2; ++t) {
                        f32x16 S = __builtin_amdgcn_mfma_f32_32x32x16_bf16(kf[0], qf[t][0], negm[FIXEDM ? 0 : t], 0, 0, 0);
#pragma unroll
                        for (int s = 1; s < 4; ++s) S = __builtin_amdgcn_mfma_f32_32x32x16_bf16(kf[s], qf[t][s], S, 0, 0, 0);
                        if (tile == 64) {
#pragma unroll
                            for (int i = 8; i < 16; ++i) S[i] = -1e30f;
                        }
                        if (!FIXEDM) {
                        float mx = fmaxf(fmaxf(S[0], S[1]), S[2]);
#pragma unroll
                        for (int i = 3; i < 15; i += 2) mx = fmaxf(fmaxf(mx, S[i]), S[i + 1]);
                        mx = fmaxf(mx, S[15]);
                        mx = fmaxf(mx, __shfl_xor(mx, 32));
                        const bool first = (tile == ftile) && (sub == 0);
                        if (first || __ballot(mx > 8.0f) != 0ull) {
                            const float d = first ? mx : fmaxf(mx, 0.f), alpha = first ? 1.0f : __builtin_amdgcn_exp2f(-d);
#pragma unroll
                            for (int i = 0; i < 16; ++i) { S[i] -= d; negm[t][i] -= d; }
#pragma unroll
                            for (int i = 0; i < 8; ++i) L[8 * t + i] *= alpha;
#pragma unroll
                            for (int dt = 0; dt < 2; ++dt)
#pragma unroll
                                for (int i = 0; i < 16; ++i) O[t][dt][i] *= alpha;
                        }
                        }
#pragma unroll
                        for (int i = 0; i < 16; ++i) S[i] = __builtin_amdgcn_exp2f(S[i]);
                        bf16x8 pf[2];
#pragma unroll
                        for (int s2 = 0; s2 < 2; ++s2) { u32x4 w; w.x = pk2(S[8 * s2], S[8 * s2 + 1]); w.y = pk2(S[8 * s2 + 2], S[8 * s2 + 3]);
                            w.z = pk2(S[8 * s2 + 4], S[8 * s2 + 5]); w.w = pk2(S[8 * s2 + 6], S[8 * s2 + 7]); pf[s2] = __builtin_bit_cast(bf16x8, w); }
#pragma unroll
                        for (int dt = 0; dt < 2; ++dt)
#pragma unroll
                            for (int s2 = 0; s2 < 2; ++s2) O[t][dt] = __builtin_amdgcn_mfma_f32_32x32x16_bf16(vf[dt][s2], pf[s2], O[t][dt], 0, 0, 0);
                        L = __builtin_amdgcn_mfma_f32_32x32x16_bf16(onesA[t], pf[0], L, 0, 0, 0);
                        L = __builtin_amdgcn_mfma_f32_32x32x16_bf16(onesA[t], pf[1], L, 0, 0, 0);
                    }
                }
                }
}
            if (tile < 64) { const int nb = buf ^ 1;
                *(u32x4*)(smem + nb * ATT_BUF + skey * ATT_ROWB + sch * 16) = kr; *(u32x4*)(smem + nb * ATT_BUF + ATT_KB + skey * ATT_ROWB + sch * 16) = vr; }
            __syncthreads();
        }
        l[0] = L[0]; l[1] = L[8];
        if (meta) {
            if (qsub != 0) {
#pragma unroll
                for (int t = 0; t < 2; ++t) { unsigned poff = (unsigned)((((hp * 3 + qsub - 1) * 2 + t) * 34) * 64 + lane) * 4u; asm volatile("" : "+v"(poff));
                    float* p = (float*)(smem + poff);
                    p[0] = negm[t][0]; p[64] = l[t];
#pragma unroll
                    for (int dt = 0; dt < 2; ++dt)
#pragma unroll
                        for (int i = 0; i < 16; ++i) p[(2 + dt * 16 + i) * 64] = O[t][dt][i]; }
            }
            __syncthreads();
            if (qsub == 0) {
#pragma unroll
                for (int t = 0; t < 2; ++t) {
                    unsigned p0off = (unsigned)(((hp * 3 * 2 + t) * 34) * 64 + lane) * 4u; asm volatile("" : "+v"(p0off));
                    const float* p0 = (const float*)(smem + p0off);
                    const float n0 = negm[t][0], n1 = p0[0], n2 = p0[(size_t)2 * 34 * 64], n3 = p0[(size_t)4 * 34 * 64];
                    const float ns = fminf(fminf(n0, n1), fminf(n2, n3));
                    const float f0 = __builtin_amdgcn_exp2f(ns - n0);
                    l[t] *= f0;
#pragma unroll
                    for (int dt = 0; dt < 2; ++dt)
#pragma unroll
                        for (int i = 0; i < 16; ++i) O[t][dt][i] *= f0;
#pragma unroll 1
                    for (int w = 0; w < 3; ++w) { const float* p = p0 + (size_t)(w * 2 * 34) * 64; const float fw = __builtin_amdgcn_exp2f(ns - p[0]);
                        l[t] += fw * p[64];
#pragma unroll
                        for (int dt = 0; dt < 2; ++dt)
#pragma unroll
                            for (int i = 0; i < 16; ++i) O[t][dt][i] += fw * p[(2 + dt * 16 + i) * 64]; }
                }
            }
            __syncthreads();
        }
        if (!meta || (qsub == 0 && r < 16)) {
#pragma unroll
            for (int t = 0; t < 2; ++t) {
                const float lt = l[t]; const float inv = 1.0f / lt;
                bf16_t* op = o + (size_t)qrow * DM + (kvh * 4 + hp * 2 + t) * 64 + 4 * h;
#pragma unroll
                for (int dt = 0; dt < 2; ++dt)
#pragma unroll
                    for (int g = 0; g < 4; ++g) { unsigned w0 = pk2(O[t][dt][4 * g] * inv, O[t][dt][4 * g + 1] * inv), w1 = pk2(O[t][dt][4 * g + 2] * inv, O[t][dt][4 * g + 3] * inv);
                        unsigned long long w = (unsigned long long)w0 | ((unsigned long long)w1 << 32);
                        *(unsigned long long*)(op + 32 * dt + 8 * g) = w; }
            }
        }
    }
}


__device__ __forceinline__ void osm_update(f32x16& S, float& m, float& l, f32x16 (&O)[2]) {
    float mx = S[0];
#pragma unroll
    for (int i = 1; i < 16; ++i) mx = fmaxf(mx, S[i]);
    mx = fmaxf(mx, __shfl_xor(mx, 32));
    const float mn = fmaxf(m, mx), alpha = __builtin_amdgcn_exp2f(m - mn);
    m = mn;
    float rs = 0.f;
#pragma unroll
    for (int i = 0; i < 16; ++i) { S[i] = __builtin_amdgcn_exp2f(S[i] - mn); rs += S[i]; }
    l = l * alpha + rs;
#pragma unroll
    for (int dt = 0; dt < 2; ++dt)
#pragma unroll
        for (int i = 0; i < 16; ++i) O[dt][i] *= alpha;
}
__device__ __forceinline__ bf16x8 pack_p(const f32x16& S, int s2) {
    u32x4 w; w.x = pk2(S[8 * s2], S[8 * s2 + 1]); w.y = pk2(S[8 * s2 + 2], S[8 * s2 + 3]); w.z = pk2(S[8 * s2 + 4], S[8 * s2 + 5]); w.w = pk2(S[8 * s2 + 6], S[8 * s2 + 7]);
    return __builtin_bit_cast(bf16x8, w);
}
__device__ __forceinline__ void osm_lazy(f32x16& S, f32x16& negm, float& l, f32x16 (&O)[2], const bool first) {
    float mx = fmaxf(fmaxf(S[0], S[1]), S[2]);
#pragma unroll
    for (int i = 3; i < 15; i += 2) mx = fmaxf(fmaxf(mx, S[i]), S[i + 1]);
    mx = fmaxf(mx, S[15]);
    mx = fmaxf(mx, __shfl_xor(mx, 32));
    if (first || __ballot(mx > 8.0f) != 0ull) {
        const float d = first ? mx : fmaxf(mx, 0.f), alpha = first ? 1.0f : __builtin_amdgcn_exp2f(-d);
        l *= alpha;
#pragma unroll
        for (int i = 0; i < 16; ++i) { S[i] -= d; negm[i] -= d; }
#pragma unroll
        for (int dt = 0; dt < 2; ++dt)
#pragma unroll
            for (int i = 0; i < 16; ++i) O[dt][i] *= alpha;
    }
    f32x2_t rs2 = {0.f, 0.f};
#pragma unroll
    for (int i = 0; i < 16; i += 2) { S[i] = __builtin_amdgcn_exp2f(S[i]); S[i + 1] = __builtin_amdgcn_exp2f(S[i + 1]); rs2 += (f32x2_t){S[i], S[i + 1]}; }
    l += rs2.x + rs2.y;
}
__device__ __forceinline__ void osm_lazy_pair(f32x16& S0, f32x16& S1, f32x16& negm, float& l, f32x16 (&O)[2]) {
    float mx = fmaxf(fmaxf(S0[0], S0[1]), S0[2]), my = fmaxf(fmaxf(S1[0], S1[1]), S1[2]);
#pragma unroll
    for (int i = 3; i < 15; i += 2) { mx = fmaxf(fmaxf(mx, S0[i]), S0[i + 1]); my = fmaxf(fmaxf(my, S1[i]), S1[i + 1]); }
    mx = fmaxf(fmaxf(mx, S0[15]), fmaxf(my, S1[15]));
    mx = fmaxf(mx, __shfl_xor(mx, 32));
    if (__ballot(mx > 8.0f) != 0ull) {
        const float d = fmaxf(mx, 0.f), alpha = __builtin_amdgcn_exp2f(-d);
        l *= alpha;
#pragma unroll
        for (int i = 0; i < 16; ++i) { S0[i] -= d; S1[i] -= d; negm[i] -= d; }
#pragma unroll
        for (int dt = 0; dt < 2; ++dt)
#pragma unroll
            for (int i = 0; i < 16; ++i) O[dt][i] *= alpha;
    }
    float ra = 0.f, rb = 0.f, rc = 0.f, rd = 0.f;
#pragma unroll
    for (int i = 0; i < 16; i += 2) { S0[i] = __builtin_amdgcn_exp2f(S0[i]); S1[i] = __builtin_amdgcn_exp2f(S1[i]); S0[i + 1] = __builtin_amdgcn_exp2f(S0[i + 1]); S1[i + 1] = __builtin_amdgcn_exp2f(S1[i + 1]);
        ra += S0[i]; rb += S1[i]; rc += S0[i + 1]; rd += S1[i + 1]; }
    l += (ra + rb) + (rc + rd);
}
__device__ __forceinline__ void osm_lazy_pair2(f32x16& S0, f32x16& S1, f32x16& Ca, f32x16& Cb, float& l, f32x16 (&O)[2]) {
    float mx = fmaxf(fmaxf(S0[0], S0[1]), S0[2]), my = fmaxf(fmaxf(S1[0], S1[1]), S1[2]);
#pragma unroll
    for (int i = 3; i < 15; i += 2) { mx = fmaxf(fmaxf(mx, S0[i]), S0[i + 1]); my = fmaxf(fmaxf(my, S1[i]), S1[i + 1]); }
    mx = fmaxf(fmaxf(mx, S0[15]), fmaxf(my, S1[15]));
    mx = fmaxf(mx, __shfl_xor(mx, 32));
    if (__ballot(mx > 8.0f) != 0ull) {
        const float d = fmaxf(mx, 0.f), alpha = __builtin_amdgcn_exp2f(-d);
        l *= alpha;
#pragma unroll
        for (int i = 0; i < 16; ++i) { S0[i] -= d; S1[i] -= d; Ca[i] -= d; Cb[i] -= d; }
#pragma unroll
        for (int dt = 0; dt < 2; ++dt)
#pragma unroll
            for (int i = 0; i < 16; ++i) O[dt][i] *= alpha;
    }
    float ra = 0.f, rb = 0.f, rc = 0.f, rd = 0.f;
#pragma unroll
    for (int i = 0; i < 16; i += 2) { S0[i] = __builtin_amdgcn_exp2f(S0[i]); S1[i] = __builtin_amdgcn_exp2f(S1[i]); S0[i + 1] = __builtin_amdgcn_exp2f(S0[i + 1]); S1[i + 1] = __builtin_amdgcn_exp2f(S1[i + 1]);
        ra += S0[i]; rb += S1[i]; rc += S0[i + 1]; rd += S1[i + 1]; }
    l += (ra + rb) + (rc + rd);
}
__device__ __forceinline__ void osm_lazy2(f32x16& S, f32x16& Ca, f32x16& Cb, float& l, f32x16 (&O)[2], const bool first) {
    float mx = fmaxf(fmaxf(S[0], S[1]), S[2]);
#pragma unroll
    for (int i = 3; i < 15; i += 2) mx = fmaxf(fmaxf(mx, S[i]), S[i + 1]);
    mx = fmaxf(mx, S[15]);
    mx = fmaxf(mx, __shfl_xor(mx, 32));
    if (first || __ballot(mx > 8.0f) != 0ull) {
        const float d = first ? mx : fmaxf(mx, 0.f), alpha = first ? 1.0f : __builtin_amdgcn_exp2f(-d);
        l *= alpha;
#pragma unroll
        for (int i = 0; i < 16; ++i) { S[i] -= d; Ca[i] -= d; Cb[i] -= d; }
#pragma unroll
        for (int dt = 0; dt < 2; ++dt)
#pragma unroll
            for (int i = 0; i < 16; ++i) O[dt][i] *= alpha;
    }
    float ra = 0.f, rb = 0.f;
#pragma unroll
    for (int i = 0; i < 16; i += 2) { S[i] = __builtin_amdgcn_exp2f(S[i]); S[i + 1] = __builtin_amdgcn_exp2f(S[i + 1]); ra += S[i]; rb += S[i + 1]; }
    l += ra + rb;
}
constexpr int NA_TBL_OFF = 2 * ATT_BUF + 4096;
__device__ __forceinline__ void na_attn_fast(const Params& P, unsigned char* smem, const int tid) {
    const bf16_t* qk = (const bf16_t*)(P.ws + WS_BIG); const bf16_t* vt = (const bf16_t*)(P.ws + WS_VT); bf16_t* o = (bf16_t*)(P.ws + WS_H);
    const float* rpb = P.in[8]; const float* mbias = P.in[9];
    const int wave = tid >> 6, lane = tid & 63, r = lane & 31, h = lane >> 5;
    const int G = gridDim.x, bx = blockIdx.x;
    const int vb = (G % 8 == 0) ? (bx % 8) * (G / 8) + bx / 8 : bx;
    const int kapr = (r & ~12) | ((r & 4) << 1) | ((r & 8) >> 1);
    const int skey = tid >> 3, sch = tid & 7;
    float* tbl = (float*)(smem + NA_TBL_OFF);
    for (int i = tid; i < 16 * 465; i += NTHREADS) tbl[i] = rpb[i] * LOG2E;
    if (tid < 64) tbl[-64 + tid] = 0.f;
    else if (tid < 192) tbl[16 * 465 + (tid - 64)] = 0.f;
    __syncthreads();
    const int rr = wave >> 1, half = wave & 1, c = 32 * half + r, cs = min(max(c - 8, 0), 48), w0 = 8 * h - cs;
    f32x16 madd[2];
#pragma unroll
    for (int tl = 0; tl < 2; ++tl)
#pragma unroll
        for (int i = 0; i < 16; ++i) madd[tl][i] = ((unsigned)(32 * tl + 16 * (i >> 3) + (i & 7) + w0) < 16u) ? 0.f : -1e30f;
    for (int U = vb; U < 4096; U += G) {
        const int rgp = U & 15, hd = (U >> 4) & 15, b = U >> 8;
        const int R0 = 4 * rgp, rg = R0 + rr, rs = min(max(rg - 4, 0), 56);
        const int jlo = min(max(R0 - 4, 0), 56), nrows = min(max(R0 - 1, 0), 56) + 8 - jlo;
        const int qrow = b * 4096 + rg * 64 + c;
        bf16x8 qf[4];
#pragma unroll
        for (int s = 0; s < 4; ++s) qf[s] = *(const bf16x8*)(qk + (size_t)qrow * 2048 + hd * 64 + 16 * s + 8 * h);
        f32x16 O[2], cm[2], zero16; float l = 0.f;
#pragma unroll
        for (int i = 0; i < 16; ++i) { zero16[i] = 0.f; cm[0][i] = madd[0][i]; cm[1][i] = madd[1][i]; }
#pragma unroll
        for (int dt = 0; dt < 2; ++dt)
#pragma unroll
            for (int i = 0; i < 16; ++i) O[dt][i] = 0.f;
        const bf16_t* kbase = qk + 1024 + hd * 64 + sch * 8;
        const bf16_t* vbase = vt + (size_t)(hd * 64 + skey) * MTOK + sch * 8;
        u32x4 kr, vr;
        { const int krow0 = b * 4096 + jlo * 64;
          kr = *(const u32x4*)(kbase + (size_t)(krow0 + skey) * 2048); vr = *(const u32x4*)(vbase + krow0); }
        {
            const bf16_t* kp = qk + (size_t)(MREAL + b * 16 + (kapr & 15)) * 2048 + 1024 + hd * 64 + 8 * h;
            const bf16_t* vh = vt + (size_t)(hd * 64 + r) * MTOK + (MREAL + b * 16 + 8 * h);
            f32x16 S = __builtin_amdgcn_mfma_f32_32x32x16_bf16(*(const bf16x8*)(kp), qf[0], zero16, 0, 0, 0);
#pragma unroll
            for (int s = 1; s < 4; ++s) S = __builtin_amdgcn_mfma_f32_32x32x16_bf16(*(const bf16x8*)(kp + 16 * s), qf[s], S, 0, 0, 0);
            const f32x4 b0 = *(const f32x4*)(mbias + hd * 16 + 8 * h), b1 = *(const f32x4*)(mbias + hd * 16 + 8 * h + 4);
#pragma unroll
            for (int i = 0; i < 4; ++i) { S[i] += b0[i] * LOG2E; S[4 + i] += b1[i] * LOG2E; }
#pragma unroll
            for (int i = 8; i < 16; ++i) S[i] = -1e30f;
            osm_lazy2(S, cm[0], cm[1], l, O, true);
            const bf16x8 pf0 = pack_p(S, 0);
#pragma unroll
            for (int dt = 0; dt < 2; ++dt) O[dt] = __builtin_amdgcn_mfma_f32_32x32x16_bf16(*(const bf16x8*)(vh + (size_t)(dt * 32) * MTOK), pf0, O[dt], 0, 0, 0);
        }
        *(u32x4*)(smem + skey * ATT_ROWB + sch * 16) = kr; *(u32x4*)(smem + ATT_KB + skey * ATT_ROWB + sch * 16) = vr;
        __syncthreads();
        const float* tp = tbl + (hd * 465 + 8 * h - c + 15);
        for (int jj = 0; jj < nrows; ++jj) {
            const int j = jlo + jj, buf = jj & 1;
            if (jj + 1 < nrows) { const int krow0 = b * 4096 + (j + 1) * 64;
                kr = *(const u32x4*)(kbase + (size_t)(krow0 + skey) * 2048); vr = *(const u32x4*)(vbase + krow0); }
            if (j >= rs && j < rs + 8) {
                const unsigned char* Kb = smem + buf * ATT_BUF; const unsigned char* Vb = Kb + ATT_KB;
                const float* tpi = tp + 31 * (j - rg + 7);
                bf16x8 kf[2][4], vf[2][2][2];
#pragma unroll
                for (int tl = 0; tl < 2; ++tl) {
#pragma unroll
                    for (int s = 0; s < 4; ++s) kf[tl][s] = *(const bf16x8*)(Kb + (tl * 32 + kapr) * ATT_ROWB + (16 * s + 8 * h) * 2);
#pragma unroll
                    for (int dt = 0; dt < 2; ++dt)
#pragma unroll
                        for (int s2 = 0; s2 < 2; ++s2) vf[tl][dt][s2] = *(const bf16x8*)(Vb + (dt * 32 + r) * ATT_ROWB + (tl * 32 + 16 * s2 + 8 * h) * 2);
                }
                f32x16 S0 = __builtin_amdgcn_mfma_f32_32x32x16_bf16(kf[0][0], qf[0], cm[0], 0, 0, 0);
                f32x16 S1 = __builtin_amdgcn_mfma_f32_32x32x16_bf16(kf[1][0], qf[0], cm[1], 0, 0, 0);
#pragma unroll
                for (int s = 1; s < 4; ++s) { S0 = __builtin_amdgcn_mfma_f32_32x32x16_bf16(kf[0][s], qf[s], S0, 0, 0, 0); S1 = __builtin_amdgcn_mfma_f32_32x32x16_bf16(kf[1][s], qf[s], S1, 0, 0, 0); }
#pragma unroll
                for (int i = 0; i < 16; ++i) { const int kq0 = 16 * (i >> 3) + (i & 7); S0[i] += tpi[kq0]; S1[i] += tpi[32 + kq0]; }
                osm_lazy_pair2(S0, S1, cm[0], cm[1], l, O);
                { const bf16x8 p00 = pack_p(S0, 0), p01 = pack_p(S0, 1), p10 = pack_p(S1, 0), p11 = pack_p(S1, 1);
#pragma unroll
                  for (int dt = 0; dt < 2; ++dt) { O[dt] = __builtin_amdgcn_mfma_f32_32x32x16_bf16(vf[0][dt][0], p00, O[dt], 0, 0, 0);
                      O[dt] = __builtin_amdgcn_mfma_f32_32x32x16_bf16(vf[0][dt][1], p01, O[dt], 0, 0, 0);
                      O[dt] = __builtin_amdgcn_mfma_f32_32x32x16_bf16(vf[1][dt][0], p10, O[dt], 0, 0, 0);
                      O[dt] = __builtin_amdgcn_mfma_f32_32x32x16_bf16(vf[1][dt][1], p11, O[dt], 0, 0, 0); } }
            }
            if (jj + 1 < nrows) { const int nb = buf ^ 1;
                *(u32x4*)(smem + nb * ATT_BUF + skey * ATT_ROWB + sch * 16) = kr; *(u32x4*)(smem + nb * ATT_BUF + ATT_KB + skey * ATT_ROWB + sch * 16) = vr; }
            __syncthreads();
        }
        const float lt = l + __shfl_xor(l, 32), inv = 1.0f / lt;
        bf16_t* op = o + (size_t)qrow * DM + hd * 64 + 4 * h;
#pragma unroll
        for (int dt = 0; dt < 2; ++dt)
#pragma unroll
            for (int g = 0; g < 4; ++g) { const unsigned w0_ = pk2(O[dt][4 * g] * inv, O[dt][4 * g + 1] * inv), w1_ = pk2(O[dt][4 * g + 2] * inv, O[dt][4 * g + 3] * inv);
                *(unsigned long long*)(op + 32 * dt + 8 * g) = (unsigned long long)w0_ | ((unsigned long long)w1_ << 32); }
    }
    for (int u = vb * 8 + wave; u < 256; u += G * 8) {
        const int hd = u & 15, b = u >> 4;
        const int qrow = MREAL + b * 16 + (r & 15);
        f32x16 O[2], negm; float l = 0.f;
#pragma unroll
        for (int i = 0; i < 16; ++i) negm[i] = 0.f;
#pragma unroll
        for (int dt = 0; dt < 2; ++dt)
#pragma unroll
            for (int i = 0; i < 16; ++i) O[dt][i] = 0.f;
        const bf16_t* qp = qk + (size_t)qrow * 2048 + hd * 64 + 8 * h;
        const bf16_t* kp = qk + (size_t)(MREAL + b * 16 + (kapr & 15)) * 2048 + 1024 + hd * 64 + 8 * h;
        const bf16_t* vh = vt + (size_t)(hd * 64 + r) * MTOK + (MREAL + b * 16 + 8 * h);
        f32x16 S = __builtin_amdgcn_mfma_f32_32x32x16_bf16(*(const bf16x8*)(kp), *(const bf16x8*)(qp), negm, 0, 0, 0);
#pragma unroll
        for (int s = 1; s < 4; ++s) S = __builtin_amdgcn_mfma_f32_32x32x16_bf16(*(const bf16x8*)(kp + 16 * s), *(const bf16x8*)(qp + 16 * s), S, 0, 0, 0);
#pragma unroll
        for (int i = 8; i < 16; ++i) S[i] = -1e30f;
        osm_lazy(S, negm, l, O, true);
        const bf16x8 pf0 = pack_p(S, 0);
#pragma unroll
        for (int dt = 0; dt < 2; ++dt) O[dt] = __builtin_amdgcn_mfma_f32_32x32x16_bf16(*(const bf16x8*)(vh + (size_t)(dt * 32) * MTOK), pf0, O[dt], 0, 0, 0);
        const float lt = l + __shfl_xor(l, 32);
        if (r < 16) {
            const float inv = 1.0f / lt;
            bf16_t* op = o + (size_t)qrow * DM + hd * 64 + 4 * h;
#pragma unroll
            for (int dt = 0; dt < 2; ++dt)
#pragma unroll
                for (int g = 0; g < 4; ++g) { const unsigned w0_ = pk2(O[dt][4 * g] * inv, O[dt][4 * g + 1] * inv), w1_ = pk2(O[dt][4 * g + 2] * inv, O[dt][4 * g + 3] * inv);
                    *(unsigned long long*)(op + 32 * dt + 8 * g) = (unsigned long long)w0_ | ((unsigned long long)w1_ << 32); }
        }
    }
}

#define LAS __attribute__((address_space(3)))
#define XB_TMO      128
#define XB_XCNT(j)  (256  + 64 * (j))
#define XB_XSUB(j)  (1280 + 64 * (j))
#define XB_XGEN(j)  (2304 + 64 * (j))
#define XB_TOP      3328
#define XB_TOPGEN   3392
#define XCD_BAR_WORDS 3456
#define XB_SPIN_CAP (1u << 18)

__device__ __forceinline__ unsigned xb_ld(unsigned* p)              { return __hip_atomic_load(p, __ATOMIC_RELAXED, __HIP_MEMORY_SCOPE_AGENT); }
__device__ __forceinline__ unsigned xb_add(unsigned* p, unsigned v) { return __hip_atomic_fetch_add(p, v, __ATOMIC_RELAXED, __HIP_MEMORY_SCOPE_AGENT); }
__device__ __forceinline__ unsigned xb_xcc_id() { return (unsigned)__builtin_amdgcn_s_getreg((3 << 11) | 20) & 0xFu; }
#define XB_SPIN(cond, bar) do { unsigned _sp = 0; while (cond) { __builtin_amdgcn_s_sleep(1); \
    if ((++_sp & 255u) == 0u) { if (xb_ld(&(bar)[XB_TMO])) break; if (_sp > XB_SPIN_CAP) { atomicAdd(&(bar)[XB_TMO], 1u); break; } } } } while (0)

struct XcdBarrier {
    unsigned* bar; unsigned x;
    volatile LAS unsigned* st;
};

__device__ __forceinline__ XcdBarrier xcd_barrier_post(unsigned* bar, volatile LAS unsigned* st) {
    XcdBarrier b; b.bar = bar; b.x = xb_xcc_id(); b.st = st;
    if (threadIdx.x == 0) (void)xb_add(&bar[XB_XCNT(b.x)], 1u);
    return b;
}
__device__ __forceinline__ void xcd_barrier_complete(unsigned* bar, unsigned x, unsigned& nloc, unsigned& nx) {
    const unsigned G = gridDim.x * gridDim.y * gridDim.z;
    unsigned sum, cnt, mine, sp = 0u;
    for (;;) {
        sum = 0u; cnt = 0u; mine = 0u;
#pragma unroll
        for (unsigned j = 0; j < 16; ++j) { const unsigned c = xb_ld(&bar[XB_XCNT(j)]); sum += c; cnt += (c > 0u) ? 1u : 0u; mine = (j == x) ? c : mine; }
        if (sum == G) break;
        __builtin_amdgcn_s_sleep(1);
        if ((++sp & 255u) == 0u) { if (xb_ld(&bar[XB_TMO])) break; if (sp > XB_SPIN_CAP) { atomicAdd(&bar[XB_TMO], 1u); break; } }
    }
    nloc = mine > 0u ? mine : 1u; nx = cnt > 0u ? cnt : 1u;
}

__device__ __forceinline__ void xcd_barrier(const XcdBarrier& b) {
    asm volatile("s_waitcnt vmcnt(0)" ::: "memory");
    __syncthreads();
    if (threadIdx.x == 0) {
        unsigned* bar = b.bar;
        __builtin_amdgcn_s_waitcnt(0);
        unsigned nloc = b.st[0], nx = b.st[1];
        if (nloc == 0u) { xcd_barrier_complete(bar, b.x, nloc, nx); b.st[0] = nloc; b.st[1] = nx; }
        const unsigned old = xb_add(&bar[XB_XSUB(b.x)], 1u);
        const unsigned gen = old / nloc;
        if (old + 1u == (gen + 1u) * nloc) {
            __builtin_amdgcn_fence(__ATOMIC_RELEASE, "agent");
            asm volatile("s_waitcnt vmcnt(0)" ::: "memory");
            const unsigned og = xb_add(&bar[XB_TOP], 1u);
            const unsigned tg = og / nx;
            if (og + 1u == (tg + 1u) * nx) xb_add(&bar[XB_TOPGEN], 1u);
            else XB_SPIN(xb_ld(&bar[XB_TOPGEN]) == tg, bar);
            __builtin_amdgcn_fence(__ATOMIC_ACQUIRE, "agent");
            xb_add(&bar[XB_XGEN(b.x)], 1u);
            asm volatile("s_waitcnt vmcnt(0)" ::: "memory");
        } else {
            XB_SPIN(xb_ld(&bar[XB_XGEN(b.x)]) == gen, bar);
            __builtin_amdgcn_fence(__ATOMIC_ACQUIRE, "agent");
            asm volatile("s_waitcnt vmcnt(0)" ::: "memory");
        }
    }
    __syncthreads();
}

#if MK_ONE_LAUNCH
#define GRID_SYNC() do { XcdBarrier xb_; xb_.bar = (unsigned*)P.ws; xb_.x = xb_xcc_id(); xb_.st = (volatile LAS unsigned*)(lds + XB_LDS_OFF); xcd_barrier(xb_); } while (0)
#else
#define GRID_SYNC() do {} while (0)
#endif
constexpr int XB_LDS_OFF = 131072;
constexpr size_t XB_WS_BYTES = 16384;
constexpr int N_PHASES = 21;
__global__ void __launch_bounds__(NTHREADS, 2) mk_fwd(Params P) {
    extern __shared__ __attribute__((aligned(16))) unsigned char smem[];
    PG8_LAS unsigned char* lds = (PG8_LAS unsigned char*)smem;
    const int G = gridDim.x, bx = blockIdx.x;
#if MK_ONE_LAUNCH
    if (threadIdx.x == 0) { ((volatile LAS unsigned*)(lds + XB_LDS_OFF))[0] = 0u; ((volatile LAS unsigned*)(lds + XB_LDS_OFF))[1] = 0u; }
    if (blockIdx.x == 0) for (int i = threadIdx.x; i < XCD_BAR_WORDS; i += NTHREADS) ((unsigned*)P.ws)[i] = 0u;
    __syncthreads();
#endif
    if (P.ph_lo == 0) {
        int tid = threadIdx.x; asm volatile("" : "+v"(tid));
        p0_weights(P, smem, tid);
        nr_phase(P, true, false, false, false, 0.f, P.in[2], P.in[2], tid);
#if MK_ONE_LAUNCH
        if (1 < P.ph_hi) cg::this_grid().sync();
        (void)xcd_barrier_post((unsigned*)P.ws, (volatile LAS unsigned*)(lds + XB_LDS_OFF));
#endif
    }
    for (int ph = (P.ph_lo == 0 ? 1 : P.ph_lo); ph < P.ph_hi; ++ph) {
        int tid = threadIdx.x; asm volatile("" : "+v"(tid));
        unsigned char* ws = P.ws; asm volatile("" : "+s"(ws));
        unsigned char* W = ws + WS_W;
        bf16_t* xn = (bf16_t*)(ws + WS_XN); bf16_t* yb = (bf16_t*)(ws + WS_Y); bf16_t* big = (bf16_t*)(ws + WS_BIG); bf16_t* vt = (bf16_t*)(ws + WS_VT);
        float* ssqp = (float*)(ws + WS_SSQ);
        const float* gains = P.in[2];
        {
            const int l = (ph - 1) / 10, s = (ph - 1) % 10;
            const float* gl = gains + (size_t)l * 6 * DM;
            if (s == 0 || s == 7) {
                const int lj = l * 2 + (s == 7);
                pg8::Gemm g{xn, (const bf16_t*)(W + lj * W_FFN_BYTES), MTOK, 2 * FF, DM}; pg8::StaticOrder S; S.init(MTOK, 2 * FF, G, bx);
                EpiSwiGLU E{big};
                pg8::gemm_phase<EpiSwiGLU, pg8::StaticOrder, true, true>(lds, g, S, E, tid);
            } else if (s == 1 || s == 5 || s == 8) {
                pg8::Gemm g; g.M = MREAL; g.N = DM;
                if (s == 5) { g.A = (const bf16_t*)(ws + WS_H); g.Bt = (const bf16_t*)(W + (l == 0 ? W_NA_O : W_GQA_O)); g.K = DM; }
                else { g.A = big; g.Bt = (const bf16_t*)(W + (l * 2 + (s == 8)) * W_FFN_BYTES + W_GU_BYTES); g.K = FF; }
                pg8::StaticOrder S; S.init(MREAL, DM, G, bx);
                EpiY E{yb, ssqp};
                pg8::gemm_phase<EpiY, pg8::StaticOrder, true, true>(lds, g, S, E, tid);
                { int tid2 = threadIdx.x; asm volatile("" : "+v"(tid2));
                  meta_gemm_y(g.A, g.Bt, g.K, yb, ssqp, smem, tid2); }
            } else if (s == 2) nr_phase(P, l == 0, true, true, false, 0.5f, gl + 1 * DM, gl + 2 * DM, tid);
            else if (s == 6) nr_phase(P, false, true, true, false, 1.0f, gl + 3 * DM, gl + 4 * DM, tid);
            else if (s == 9) nr_phase(P, false, true, true, l == 1, 0.5f, gl + 5 * DM, gains + (size_t)((l + 1) % 2) * 6 * DM, tid);
            else if (s == 3) {
                const float* rc = (const float*)(ws + WS_ROPE);
                if (l == 0) {
                    pg8::Gemm g{xn, (const bf16_t*)(W + W_NA_QK), MTOK, 2048, DM}; pg8::StaticOrder S; S.init(MTOK, 2048, G, bx);
                    EpiQK<false> E{big, 2048, 0.125f * LOG2E, nullptr, nullptr, nullptr, nullptr};
                    pg8::gemm_phase<EpiQK<false>, pg8::StaticOrder, true, true>(lds, g, S, E, tid);
                } else {
                    pg8::Gemm g{xn, (const bf16_t*)(W + W_GQA_QK), MTOK, 1280, DM}; pg8::StaticOrder S; S.init(MTOK, 1280, G, bx);
                    EpiQK<true> E{big, 1280, 0.125f * LOG2E, P.in[12], P.in[13], rc, rc + 1024};
                    pg8::gemm_phase<EpiQK<true>, pg8::StaticOrder, true, true>(lds, g, S, E, tid);
                }
                { const int mv = (l == 0) ? 1024 : 256;
                  int tid = threadIdx.x; asm volatile("" : "+v"(tid));
                  pg8::Gemm g{(const bf16_t*)(W + (l == 0 ? W_NA_V : W_GQA_V)), xn, mv, MTOK, DM}; pg8::StaticOrder S; S.init(mv, MTOK, G, bx);
                  EpiPlain E{vt, (size_t)MTOK};
                  pg8::gemm_phase<EpiPlain, pg8::StaticOrder, true, true>(lds, g, S, E, tid); }
            } else {

#ifndef NO_ATTN
                if (l == 0) {
#if NA_FAST
                    na_attn_fast(P, smem, tid);
#else
                    na_attn_naive(P, tid);
#endif
                } else {
#if GQA_FAST
                    {
                        const int ln = tid & 63;
                        float gq = fabsf(P.in[12][ln]), gk = fabsf(P.in[13][ln]);
#pragma unroll
                        for (int o = 32; o >= 1; o >>= 1) { gq = fmaxf(gq, __shfl_xor(gq, o)); gk = fmaxf(gk, __shfl_xor(gk, o)); }
                        const float bnd = 8.0f * LOG2E * gq * gk * 1.02f + 0.5f;
                        if (bnd < 50.0f) gqa_attn_fast<true>(P, smem, tid, bnd); else gqa_attn_fast<false>(P, smem, tid, 0.f);
                    }
#else
                    gqa_attn_naive(P, tid);
#endif
                }
#endif

            }
        }
        if (ph + 1 < P.ph_hi) GRID_SYNC();
    }
}

extern "C" void kernel_launch(void* const* d_in, const int* in_sizes, int n_in, void* d_out, int out_size, void* d_ws, size_t ws_size, hipStream_t stream) {
    static int grid = 0;
    if (grid == 0) {
        if (n_in != 14 || out_size != MREAL * DM || ws_size < WS_END) { fprintf(stderr, "kernel_launch: unexpected shapes (n_in %d out %d ws %zu)\n", n_in, out_size, ws_size); grid = -1; return; }
        int dev = 0, cus = 0, per_cu = 0;
        hipGetDevice(&dev); hipDeviceGetAttribute(&cus, hipDeviceAttributeMultiprocessorCount, dev);
        if (hipFuncSetAttribute((const void*)mk_fwd, hipFuncAttributeMaxDynamicSharedMemorySize, LDS_BYTES) != hipSuccess) { fprintf(stderr, "kernel_launch: hipFuncSetAttribute failed\n"); grid = -1; return; }
        if (hipOccupancyMaxActiveBlocksPerMultiprocessor(&per_cu, (const void*)mk_fwd, NTHREADS, LDS_BYTES) != hipSuccess || per_cu < 1) { fprintf(stderr, "kernel_launch: occupancy query gave %d\n", per_cu); per_cu = 1; }
        (void)hipGetLastError();
        grid = cus * per_cu;
    }
    if (grid < 0) return;
    Params p{};
    for (int i = 0; i < 14; ++i) p.in[i] = (const float*)d_in[i];
    p.out = (float*)d_out; p.ws = (unsigned char*)d_ws;
#if MK_ONE_LAUNCH
    p.ph_lo = 0; p.ph_hi = N_PHASES;
    void* args[] = {&p};
    hipError_t e = hipLaunchCooperativeKernel((const void*)mk_fwd, dim3(grid), dim3(NTHREADS), args, LDS_BYTES, stream);
    if (e != hipSuccess) fprintf(stderr, "cooperative launch failed: %s (grid %d)\n", hipGetErrorString(e), grid);
#else
    for (int ph = 0; ph < N_PHASES; ++ph) {
        p.ph_lo = ph; p.ph_hi = ph + 1;
        for (int rep = 0; rep < (int)((DUP_MASK >> ph) & 1u) + 1; ++rep)
            hipLaunchKernelGGL(mk_fwd, dim3(grid), dim3(NTHREADS), LDS_BYTES, stream, p);
    }
#endif
}
```

```cpp
#include <hip/hip_runtime.h>
#include <hip/hip_cooperative_groups.h>
#include <cstdio>
#include <cstdint>
namespace cg = cooperative_groups;
#ifndef MK_ONE_LAUNCH
#define MK_ONE_LAUNCH 1
#endif
#ifndef NA_FAST
#define NA_FAST 1
#endif
#ifndef GQA_FAST
#define GQA_FAST 1
#endif
#ifndef DUP_MASK
#define DUP_MASK 0u
#endif
#ifndef DUP_VARIANT
#define DUP_VARIANT 0
#endif
namespace pg8 {
#define PG8_LAS __attribute__((address_space(3)))
typedef unsigned short bf16_t;
typedef short bf16x8 __attribute__((ext_vector_type(8)));
typedef float f32x4 __attribute__((ext_vector_type(4)));
typedef unsigned u32x4 __attribute__((ext_vector_type(4)));
constexpr int BM = 256, BK = 64, HALF = 128, HTB = HALF * BK * 2  , STAGE_BYTES = 8 * HTB, NXCD = 8, WGM = 8;

__host__ __device__ __forceinline__ int lds_byte(int r, int c) { const int st = (r >> 4) * 2 + (c >> 5), rr = r & 15, cc = c & 31, ob = rr * 64 + cc * 2; return st * 1024 + (ob ^ (((ob >> 9) & 1) << 5)); }
__host__ __device__ __forceinline__ void stage_rc(int b, int& R, int& C) { const int st = b / 1024, sb = b % 1024, swz = sb ^ (((sb >> 9) & 1) << 5); R = (st >> 1) * 16 + swz / 64; C = (st & 1) * 32 + (swz % 64) / 2; }
__host__ __device__ __forceinline__ int perm32(int rho) { const int n = rho >> 4, i = rho & 15; return 8 * (i >> 2) + 4 * n + (i & 3); }

struct Unit { int pm, pn; };
struct Gemm { const bf16_t* A; const bf16_t* Bt; int M, N, K; };

struct StaticOrder {
    int nM, nN, nwg, G, c;
    __host__ __device__ void init(int M, int N, int G_, int c_) { nM = M / BM; nN = N / BM; nwg = nM * nN; G = G_; c = c_; }
    __host__ __device__ bool next(int i, Unit& u) const {
        const long L = (long)i * G + c; if (L >= nwg) return false;
        int wgid = (int)L; { const int q = nwg / NXCD, r = nwg % NXCD, xcd = wgid % NXCD, off = wgid / NXCD; wgid = (xcd < r ? xcd * (q + 1) : r * (q + 1) + (xcd - r) * q) + off; }
        const int nig = WGM * nN, gid = wgid / nig, fm = gid * WGM, gsz = (nM - fm) < WGM ? (nM - fm) : WGM;
        u.pm = fm + ((wgid % nig) % gsz); u.pn = (wgid % nig) / gsz; return true;
    }
    __device__ __forceinline__ void a_ready(const Unit&) const {}
    __device__ __forceinline__ void done(const Unit&) const {}
};

__device__ __forceinline__ unsigned cvt_pk_bf16(float lo, float hi) { unsigned r; asm volatile("v_cvt_pk_bf16_f32 %0, %1, %2" : "=v"(r) : "v"(lo), "v"(hi)); return r; }
template <class Epi, class Sched, bool ALIGN_EPI = false, bool SP2 = false>
__device__ __forceinline__ void gemm_phase(PG8_LAS unsigned char* lds, const Gemm g, const Sched& S, const Epi& E, const int tid) {
    const int wid = __builtin_amdgcn_readfirstlane(tid >> 6), lane = tid & 63, wr = wid >> 2, wc = wid & 3, fr = lane & 15, fq = lane >> 4;
    const int K = g.K, nt = K / BK;
    unsigned voffA[2], voffB[2];
#pragma unroll
    for (int i = 0; i < 2; ++i) { int R, C; stage_rc(tid * 16 + i * 8192, R, C); const int Rb = Epi::PERM ? ((R & ~31) + perm32(R & 31)) : R;
        voffA[i] = (unsigned)(R * K + C) * 2u; voffB[i] = (unsigned)(Rb * K + C) * 2u; }
    const size_t kstep = (size_t)(BK * 2);
    const size_t hstep = (size_t)HALF * K * 2;
    const size_t tstep = 2 * hstep;
    const unsigned ldsw = (unsigned)wid * 1024u;
    const int aoff = lds_byte(wr * 64 + fr, fq * 8), boff = lds_byte(wc * 32 + fr, fq * 8);
#define PG8_SA(b, h) (((b) * 2 + (h)) * HTB)
#define PG8_SB(b, h) ((4 + (b) * 2 + (h)) * HTB)
#define PG8_STAGE(bufoff, gbase, voff) do { _Pragma("unroll") for (int _i = 0; _i < 2; ++_i) \
        __builtin_amdgcn_global_load_lds((const unsigned*)((const char*)(gbase) + (voff)[_i]), (PG8_LAS unsigned*)(lds + (bufoff) + ldsw + _i * 8192), 16, 0, 0); } while (0)
#define PG8_LDA(dst, b, h) do { _Pragma("unroll") for (int m = 0; m < 4; ++m) _Pragma("unroll") for (int k = 0; k < 2; ++k) dst[m][k] = *(const PG8_LAS bf16x8*)(lds + PG8_SA(b, h) + aoff + m * 2048 + k * 1024); } while (0)
#define PG8_LDB(dst, b, h) do { _Pragma("unroll") for (int n = 0; n < 2; ++n) _Pragma("unroll") for (int k = 0; k < 2; ++k) dst[n][k] = *(const PG8_LAS bf16x8*)(lds + PG8_SB(b, h) + boff + n * 2048 + k * 1024); } while (0)
#define PG8_MMA(ai, bj, At, Bt) do { __builtin_amdgcn_s_setprio(1); _Pragma("unroll") for (int m = 0; m < 4; ++m) _Pragma("unroll") for (int n = 0; n < 2; ++n) _Pragma("unroll") for (int k = 0; k < 2; ++k) \
        acc[ai][bj][m][n] = __builtin_amdgcn_mfma_f32_16x16x32_bf16(Bt[n][k], At[m][k], acc[ai][bj][m][n], 0, 0, 0); __builtin_amdgcn_s_setprio(0); } while (0)
#define PG8_WAIT_V(n) asm volatile("s_waitcnt vmcnt(" #n ")" ::: "memory")
#define PG8_WAIT_L(n) asm volatile("s_waitcnt lgkmcnt(" #n ")" ::: "memory")
#define PG8_BAR __builtin_amdgcn_s_barrier()
#define PG8_SCHED __builtin_amdgcn_sched_barrier(0)
    Unit cur, nxt; int ui = 0;
    if (!S.next(0, cur)) return;
    f32x4 acc[2][2][4][2];
#pragma unroll
    for (int a = 0; a < 2; ++a)
#pragma unroll
        for (int b = 0; b < 2; ++b)
#pragma unroll
            for (int m = 0; m < 4; ++m)
#pragma unroll
                for (int n = 0; n < 2; ++n) acc[a][b][m][n] = (f32x4){0.f, 0.f, 0.f, 0.f};
    bf16x8 At[4][2], B0[2][2], B1[2][2];
    const char* cA = (const char*)g.A + (size_t)cur.pm * tstep; const char* cB = (const char*)g.Bt + (size_t)cur.pn * tstep;
    S.a_ready(cur);
    if constexpr (SP2) {
        PG8_STAGE(PG8_SB(0, 0), cB, voffB); PG8_STAGE(PG8_SB(0, 1), cB + hstep, voffB); PG8_STAGE(PG8_SA(0, 0), cA, voffA); PG8_STAGE(PG8_SA(0, 1), cA + hstep, voffA);
        if (wr == 1) PG8_BAR;
        PG8_WAIT_V(2); PG8_BAR;
        PG8_STAGE(PG8_SB(1, 0), cB + kstep, voffB); PG8_STAGE(PG8_SA(1, 0), cA + kstep, voffA); PG8_STAGE(PG8_SB(1, 1), cB + hstep + kstep, voffB);
        PG8_WAIT_V(6); PG8_BAR;
    } else {
        PG8_STAGE(PG8_SB(0, 0), cB, voffB); PG8_STAGE(PG8_SA(0, 0), cA, voffA); PG8_STAGE(PG8_SB(0, 1), cB + hstep, voffB); PG8_STAGE(PG8_SA(0, 1), cA + hstep, voffA);
        if (wr == 1) PG8_BAR;
        PG8_WAIT_V(4); PG8_BAR;
        PG8_STAGE(PG8_SB(1, 0), cB + kstep, voffB); PG8_STAGE(PG8_SA(1, 0), cA + kstep, voffA); PG8_STAGE(PG8_SB(1, 1), cB + hstep + kstep, voffB);
        PG8_WAIT_V(6); PG8_BAR;
    }
    for (;;) {
        const bool has_next = S.next(ui + 1, nxt);
        const char* nA = has_next ? (const char*)g.A + (size_t)nxt.pm * tstep : cA; const char* nB = has_next ? (const char*)g.Bt + (size_t)nxt.pn * tstep : cB;
        for (int t = 0; t < nt; t += 2) {
            const bool last = (t == nt - 2);
            const char* a1 = cA + (size_t)(t + 1) * kstep;
            const char* a2 = last ? nA : cA + (size_t)(t + 2) * kstep; const char* b2 = last ? nB : cB + (size_t)(t + 2) * kstep;
            const char* a3 = a2 + kstep; const char* b3 = b2 + kstep;
            if (last && has_next) S.a_ready(nxt);
            if constexpr (SP2) {
            PG8_LDB(B0, 0, 0); PG8_LDB(B1, 0, 1); PG8_SCHED; PG8_LDA(At, 0, 0); PG8_STAGE(PG8_SA(1, 1), a1 + hstep, voffA);
            PG8_WAIT_V(8); PG8_WAIT_L(0); PG8_BAR; PG8_MMA(0, 0, At, B0); PG8_MMA(0, 1, At, B1); PG8_BAR; PG8_SCHED;
            PG8_LDA(At, 0, 1); PG8_STAGE(PG8_SB(0, 0), b2, voffB); PG8_STAGE(PG8_SB(0, 1), b2 + hstep, voffB); PG8_STAGE(PG8_SA(0, 0), a2, voffA);
            PG8_WAIT_V(8); PG8_WAIT_L(0); PG8_BAR; PG8_MMA(1, 0, At, B0); PG8_MMA(1, 1, At, B1); PG8_BAR; PG8_SCHED;
            PG8_LDB(B0, 1, 0); PG8_LDB(B1, 1, 1); PG8_SCHED; PG8_LDA(At, 1, 0); PG8_STAGE(PG8_SA(0, 1), a2 + hstep, voffA);
            PG8_WAIT_V(8); PG8_WAIT_L(0); PG8_BAR; PG8_MMA(0, 0, At, B0); PG8_MMA(0, 1, At, B1); PG8_BAR; PG8_SCHED;
            PG8_LDA(At, 1, 1); PG8_STAGE(PG8_SB(1, 0), b3, voffB); PG8_STAGE(PG8_SB(1, 1), b3 + hstep, voffB); PG8_STAGE(PG8_SA(1, 0), a3, voffA);
            PG8_WAIT_V(8); PG8_WAIT_L(0); PG8_BAR; PG8_MMA(1, 0, At, B0); PG8_MMA(1, 1, At, B1); PG8_BAR; PG8_SCHED;
            } else {
            PG8_LDB(B0, 0, 0); PG8_SCHED; PG8_LDA(At, 0, 0); PG8_STAGE(PG8_SA(1, 1), a1 + hstep, voffA);
            PG8_WAIT_L(8); PG8_BAR; PG8_WAIT_L(0); PG8_MMA(0, 0, At, B0); PG8_BAR; PG8_SCHED;
            PG8_LDB(B1, 0, 1); PG8_STAGE(PG8_SB(0, 0), b2, voffB);
            PG8_BAR; PG8_WAIT_L(0); PG8_MMA(0, 1, At, B1); PG8_BAR;
            PG8_LDA(At, 0, 1); PG8_STAGE(PG8_SA(0, 0), a2, voffA);
            PG8_BAR; PG8_WAIT_L(0); PG8_MMA(1, 0, At, B0); PG8_BAR; PG8_SCHED;
            PG8_STAGE(PG8_SB(0, 1), b2 + hstep, voffB);
            PG8_WAIT_V(6); PG8_BAR; PG8_MMA(1, 1, At, B1); PG8_BAR;
            PG8_LDB(B0, 1, 0); PG8_SCHED; PG8_LDA(At, 1, 0); PG8_STAGE(PG8_SA(0, 1), a2 + hstep, voffA);
            PG8_WAIT_L(8); PG8_BAR; PG8_WAIT_L(0); PG8_MMA(0, 0, At, B0); PG8_BAR; PG8_SCHED;
            PG8_LDB(B1, 1, 1); PG8_STAGE(PG8_SB(1, 0), b3, voffB);
            PG8_BAR; PG8_WAIT_L(0); PG8_MMA(0, 1, At, B1); PG8_BAR;
            PG8_LDA(At, 1, 1); PG8_STAGE(PG8_SA(1, 0), a3, voffA);
            PG8_BAR; PG8_WAIT_L(0); PG8_MMA(1, 0, At, B0); PG8_BAR; PG8_SCHED;
            PG8_STAGE(PG8_SB(1, 1), b3 + hstep, voffB);
            PG8_WAIT_V(6); PG8_BAR; PG8_MMA(1, 1, At, B1); PG8_BAR;
            }
        }
        if constexpr (ALIGN_EPI) { if (wr == 0) PG8_BAR; }
        if constexpr (!Epi::AFTER_DRAIN) { E(acc, cur, wr, wc, fr, fq); S.done(cur); }
        if (!has_next) break;
#pragma unroll
        for (int a = 0; a < 2; ++a)
#pragma unroll
            for (int b = 0; b < 2; ++b)
#pragma unroll
                for (int m = 0; m < 4; ++m)
#pragma unroll
                    for (int n = 0; n < 2; ++n) acc[a][b][m][n] = (f32x4){0.f, 0.f, 0.f, 0.f};
        cur = nxt; cA = nA; cB = nB; ++ui;
        if constexpr (ALIGN_EPI) { if (wr == 1) PG8_BAR; }
    }
    PG8_WAIT_V(0);
    if constexpr (!ALIGN_EPI) { if (wr == 0) PG8_BAR; }
    PG8_BAR;
    if constexpr (Epi::AFTER_DRAIN) { E.fused(acc, cur, wr, wc, fr, fq, lds, wid, lane); S.done(cur); }
#undef PG8_SA
#undef PG8_SB
#undef PG8_STAGE
#undef PG8_LDA
#undef PG8_LDB
#undef PG8_MMA
#undef PG8_WAIT_V
#undef PG8_WAIT_L
#undef PG8_BAR
#undef PG8_SCHED
}
}

using pg8::bf16_t; using pg8::bf16x8; using pg8::f32x4; using pg8::u32x4; using pg8::Unit;
constexpr int DM = 1024, NB = 16, SEQ = 4096, NMETA = 16, MREAL = NB * SEQ  , MTOK = MREAL + NB * NMETA  ;
constexpr int FF = 2816, NH = 16, HD = 64;
constexpr float EPS = 1e-6f, LOG2E = 1.4426950408889634f;

constexpr size_t MiB = 1u << 20;
constexpr size_t WS_ROPE = 512 * 1024;
constexpr size_t WS_SSQ = 1 * MiB;
constexpr size_t WS_RMS = 6 * MiB;
constexpr size_t WS_W = 8 * MiB;
constexpr size_t W_GU_BYTES = (size_t)2 * FF * DM * 2, W_DN_BYTES = (size_t)DM * FF * 2, W_FFN_BYTES = W_GU_BYTES + W_DN_BYTES;
constexpr size_t W_NA = 4 * W_FFN_BYTES, W_NA_QK = W_NA, W_NA_V = W_NA + (size_t)2048 * DM * 2, W_NA_O = W_NA_V + (size_t)DM * DM * 2;
constexpr size_t W_GQA = W_NA_O + (size_t)DM * DM * 2, W_GQA_QK = W_GQA, W_GQA_V = W_GQA + (size_t)1280 * DM * 2, W_GQA_O = W_GQA_V + (size_t)256 * DM * 2;
constexpr size_t W_END = W_GQA_O + (size_t)DM * DM * 2;
static_assert(W_END <= 88 * MiB, "weights region");
constexpr size_t WS_H = 96 * MiB;
constexpr size_t WS_XN = 353 * MiB;
constexpr size_t WS_Y = 482 * MiB;
constexpr size_t WS_BIG = 611 * MiB;
constexpr size_t WS_VT = WS_BIG + (size_t)MTOK * 2048 * 2;
constexpr size_t WS_END = WS_VT + (size_t)DM * MTOK * 2;
static_assert(WS_END <= 1024 * MiB && WS_BIG + (size_t)MTOK * FF * 2 <= 1024 * MiB, "workspace");
static_assert(WS_H + (size_t)MTOK * DM * 4 <= WS_XN && WS_XN + (size_t)MTOK * DM * 2 <= WS_Y && WS_Y + (size_t)MTOK * DM * 2 <= WS_BIG, "workspace map");

constexpr int LDS_BYTES = 135168;
constexpr int NTHREADS = 512;

struct Params { const float* in[14]; float* out; unsigned char* ws; int ph_lo, ph_hi; };

typedef float f32x2_t __attribute__((ext_vector_type(2)));
typedef __bf16 bf16x2_t __attribute__((ext_vector_type(2)));
__device__ __forceinline__ unsigned pk2(float lo, float hi) { const f32x2_t v = {lo, hi}; const bf16x2_t b = __builtin_convertvector(v, bf16x2_t); return __builtin_bit_cast(unsigned, b); }
__device__ __forceinline__ float bf_lo(unsigned w) { return __uint_as_float(w << 16); }
__device__ __forceinline__ float bf_hi(unsigned w) { return __uint_as_float(w & 0xffff0000u); }
__device__ __forceinline__ float wave_sum(float v) {
#pragma unroll
    for (int o = 32; o >= 1; o >>= 1) v += __shfl_xor(v, o);
    return v;
}

struct EpiSwiGLU {
    static constexpr bool PERM = true, AFTER_DRAIN = false;
    bf16_t* O;
    __device__ __forceinline__ void operator()(const f32x4 (&acc)[2][2][4][2], const Unit& u, int wr, int wc, int fr, int fq) const {
        const int row0 = u.pm * 256 + wr * 64 + fr, col0 = u.pn * 128 + wc * 32 + 8 * fq;
#pragma unroll
        for (int ai = 0; ai < 2; ++ai)
#pragma unroll
            for (int m = 0; m < 4; ++m) {
                bf16_t* p = O + (size_t)(row0 + ai * 128 + m * 16) * FF + col0;
                float h[8];
#pragma unroll
                for (int n = 0; n < 2; ++n)
#pragma unroll
                    for (int e = 0; e < 4; ++e) { const float gneg = acc[ai][0][m][n][e], ups = acc[ai][1][m][n][e];
                        h[n * 4 + e] = gneg * ups * __builtin_amdgcn_rcpf(1.0f + __builtin_amdgcn_exp2f(gneg)); }
                u32x4 w; w.x = pk2(h[0], h[1]); w.y = pk2(h[2], h[3]); w.z = pk2(h[4], h[5]); w.w = pk2(h[6], h[7]);
                *(u32x4*)p = w;
            }
    }
};
struct EpiY {
    static constexpr bool PERM = true, AFTER_DRAIN = false;
    bf16_t* Y; float* ssqp;
    __device__ __forceinline__ void operator()(const f32x4 (&acc)[2][2][4][2], const Unit& u, int wr, int wc, int fr, int fq) const {
        const int row0 = u.pm * 256 + wr * 64 + fr, col0 = u.pn * 256 + wc * 32 + 8 * fq;
#pragma unroll
        for (int ai = 0; ai < 2; ++ai)
#pragma unroll
            for (int m = 0; m < 4; ++m) {
                const int row = row0 + ai * 128 + m * 16; float s = 0.f;
#pragma unroll
                for (int bj = 0; bj < 2; ++bj) { const f32x4 v0 = acc[ai][bj][m][0], v1 = acc[ai][bj][m][1];
                    s += (v0[0] * v0[0] + v0[1] * v0[1]) + (v0[2] * v0[2] + v0[3] * v0[3]) + (v1[0] * v1[0] + v1[1] * v1[1]) + (v1[2] * v1[2] + v1[3] * v1[3]);
                    u32x4 w; w.x = pk2(v0[0], v0[1]); w.y = pk2(v0[2], v0[3]); w.z = pk2(v1[0], v1[1]); w.w = pk2(v1[2], v1[3]);
                    *(u32x4*)(Y + (size_t)row * DM + col0 + bj * 128) = w; }
                s += __shfl_xor(s, 16); s += __shfl_xor(s, 32);
                if (fq == 0) ssqp[(size_t)row * 16 + u.pn * 4 + wc] = s;
            }
    }
};
struct EpiPlain {
    static constexpr bool PERM = true, AFTER_DRAIN = false;
    bf16_t* O; size_t ldc;
    __device__ __forceinline__ void operator()(const f32x4 (&acc)[2][2][4][2], const Unit& u, int wr, int wc, int fr, int fq) const {
        const int row0 = u.pm * 256 + wr * 64 + fr, col0 = u.pn * 256 + wc * 32 + 8 * fq;
#pragma unroll
        for (int ai = 0; ai < 2; ++ai)
#pragma unroll
            for (int m = 0; m < 4; ++m)
#pragma unroll
                for (int bj = 0; bj < 2; ++bj) { const f32x4 v0 = acc[ai][bj][m][0], v1 = acc[ai][bj][m][1];
                    u32x4 w; w.x = pk2(v0[0], v0[1]); w.y = pk2(v0[2], v0[3]); w.z = pk2(v1[0], v1[1]); w.w = pk2(v1[2], v1[3]);
                    *(u32x4*)(O + (size_t)(row0 + ai * 128 + m * 16) * ldc + col0 + bj * 128) = w; }
    }
};
template <bool GQA> struct EpiQK {
    static constexpr bool PERM = true, AFTER_DRAIN = false;
    bf16_t* O; int ldo; float qscale; const float* qgain; const float* kgain; const float* ropec; const float* ropes;
    __device__ __forceinline__ void operator()(const f32x4 (&acc)[2][2][4][2], const Unit& u, int wr, int wc, int fr, int fq) const {
        const bool isq = u.pn < 4; const float sc = isq ? qscale : 1.0f;
        const int colb = 64 * (4 * u.pn + wc) + 8 * fq;
        f32x4 gn[2][2];
        if (GQA) { const float* gp = isq ? qgain : kgain;
#pragma unroll
            for (int bj = 0; bj < 2; ++bj)
#pragma unroll
                for (int n = 0; n < 2; ++n) gn[bj][n] = *(const f32x4*)(gp + 32 * bj + 16 * n + 4 * fq); }
#pragma unroll
        for (int ai = 0; ai < 2; ++ai)
#pragma unroll
            for (int m = 0; m < 4; ++m) {
                const int row = u.pm * 256 + ai * 128 + wr * 64 + m * 16 + fr;
                f32x4 x[2][2];
#pragma unroll
                for (int bj = 0; bj < 2; ++bj)
#pragma unroll
                    for (int n = 0; n < 2; ++n) x[bj][n] = acc[ai][bj][m][n];
                if (GQA) {
                    float s = 0.f;
#pragma unroll
                    for (int bj = 0; bj < 2; ++bj)
#pragma unroll
                        for (int n = 0; n < 2; ++n) s += (x[bj][n][0] * x[bj][n][0] + x[bj][n][1] * x[bj][n][1]) + (x[bj][n][2] * x[bj][n][2] + x[bj][n][3] * x[bj][n][3]);
                    s += __shfl_xor(s, 16); s += __shfl_xor(s, 32);
                    const float rstd = rsqrtf(s * (1.0f / 64.0f) + EPS);
#pragma unroll
                    for (int bj = 0; bj < 2; ++bj)
#pragma unroll
                        for (int n = 0; n < 2; ++n) x[bj][n] = x[bj][n] * rstd * gn[bj][n];
                    if (u.pm < 256) {
                        const int sidx = row & 4095; const int pos[2] = {sidx >> 6, sidx & 63};
#pragma unroll
                        for (int bj = 0; bj < 2; ++bj) {
                            const f32x4 c = *(const f32x4*)(ropec + pos[bj] * 16 + 4 * fq), sn = *(const f32x4*)(ropes + pos[bj] * 16 + 4 * fq);
                            const f32x4 x1 = x[bj][0], x2 = x[bj][1];
                            x[bj][0] = x1 * c - x2 * sn; x[bj][1] = x2 * c + x1 * sn;
                        }
                    }
                }
#pragma unroll
                for (int bj = 0; bj < 2; ++bj) { const f32x4 v0 = x[bj][0] * sc, v1 = x[bj][1] * sc;
                    u32x4 w; w.x = pk2(v0[0], v0[1]); w.y = pk2(v0[2], v0[3]); w.z = pk2(v1[0], v1[1]); w.w = pk2(v1[2], v1[3]);
                    *(u32x4*)(O + (size_t)row * ldo + colb + 32 * bj) = w; }
            }
    }
};


__device__ __forceinline__ void meta_gemm_y(const bf16_t* A, const bf16_t* Wt, const int K, bf16_t* Y, float* ssqp, unsigned char* smem, const int tid) {
    const int wave = tid >> 6, lane = tid & 63, fr = lane & 15, fq = lane >> 4;
    float* red = (float*)smem;
    const int kw = K >> 3;
    for (int su = blockIdx.x; su < 256; su += gridDim.x) {
        const int rt = su >> 4, ct = su & 15;
        const bf16_t* ap = A + (size_t)(MREAL + 16 * rt + fr) * K + wave * kw + 8 * fq;
        const bf16_t* bp = Wt + (size_t)(64 * ct + fr) * K + wave * kw + 8 * fq;
        f32x4 acc[4];
#pragma unroll
        for (int c4 = 0; c4 < 4; ++c4) acc[c4] = (f32x4){0.f, 0.f, 0.f, 0.f};
#pragma unroll 4
        for (int k = 0; k < kw; k += 32) {
            const bf16x8 a = *(const bf16x8*)(ap + k);
#pragma unroll
            for (int c4 = 0; c4 < 4; ++c4) acc[c4] = __builtin_amdgcn_mfma_f32_16x16x32_bf16(a, *(const bf16x8*)(bp + (size_t)(16 * c4) * K + k), acc[c4], 0, 0, 0);
        }
#pragma unroll
        for (int c4 = 0; c4 < 4; ++c4)
#pragma unroll
            for (int i = 0; i < 4; ++i) red[(wave * 16 + 4 * fq + i) * 64 + 16 * c4 + fr] = acc[c4][i];
        __syncthreads();
        const int row = 2 * wave + (lane >> 5), cp = lane & 31;
        float s0 = 0.f, s1 = 0.f;
#pragma unroll
        for (int w = 0; w < 8; ++w) { const f32x2_t v = *(const f32x2_t*)(red + (w * 16 + row) * 64 + 2 * cp); s0 += v.x; s1 += v.y; }
        const int grow = MREAL + 16 * rt + row;
        *(unsigned*)(Y + (size_t)grow * DM + 64 * ct + 2 * cp) = pk2(s0, s1);
        float q = s0 * s0 + s1 * s1;
        q += __shfl_xor(q, 1); q += __shfl_xor(q, 2); q += __shfl_xor(q, 4); q += __shfl_xor(q, 8); q += __shfl_xor(q, 16);
        if (cp == 0) ssqp[(size_t)grow * 16 + ct] = q;
        __syncthreads();
    }
}

__device__ __forceinline__ void p0_weights(const Params& P, unsigned char* smem, const int tid) {
    float* tile = (float*)smem;
    unsigned char* W = P.ws + WS_W;
    for (int job = 0; job < 14; ++job) {
        const float* srcA; const float* srcB = nullptr; int ld, N, K, kind, coloff = 0; bf16_t* dst;
        const float* gk = nullptr;
        if (job < 8) { const int lj = job >> 1, dn = job & 1;
            if (!dn) gk = P.in[2] + (size_t)((lj >> 1) * 6 + ((lj & 1) ? 4 : 0)) * DM;
            if (!dn) { kind = 0; srcA = P.in[3] + (size_t)lj * DM * FF; srcB = P.in[4] + (size_t)lj * DM * FF; ld = FF; N = 2 * FF; K = DM; dst = (bf16_t*)(W + lj * W_FFN_BYTES); }
            else     { kind = 1; srcA = P.in[5] + (size_t)lj * FF * DM; ld = DM; N = DM; K = FF; dst = (bf16_t*)(W + lj * W_FFN_BYTES + W_GU_BYTES); } }
        else if (job == 8)  { gk = P.in[2] + (size_t)(0 * 6 + 2) * DM; kind = 2; srcA = P.in[6];  ld = 3072; N = 2048; K = DM; dst = (bf16_t*)(W + W_NA_QK); }
        else if (job == 9)  { gk = P.in[2] + (size_t)(0 * 6 + 2) * DM; kind = 1; srcA = P.in[6];  ld = 3072; N = 1024; K = DM; coloff = 2048; dst = (bf16_t*)(W + W_NA_V); }
        else if (job == 10) { kind = 1; srcA = P.in[7];  ld = 1024; N = 1024; K = DM; dst = (bf16_t*)(W + W_NA_O); }
        else if (job == 11) { gk = P.in[2] + (size_t)(1 * 6 + 2) * DM; kind = 3; srcA = P.in[10]; ld = 1536; N = 1280; K = DM; dst = (bf16_t*)(W + W_GQA_QK); }
        else if (job == 12) { gk = P.in[2] + (size_t)(1 * 6 + 2) * DM; kind = 1; srcA = P.in[10]; ld = 1536; N = 256;  K = DM; coloff = 1280; dst = (bf16_t*)(W + W_GQA_V); }
        else                { kind = 1; srcA = P.in[11]; ld = 1024; N = 1024; K = DM; dst = (bf16_t*)(W + W_GQA_O); }
        const int ntn = N / 64, ntk = K / 64;
        for (int t = blockIdx.x; t < ntn * ntk; t += gridDim.x) {
            const int n0 = (t % ntn) * 64, k0 = (t / ntn) * 64;
            const int nn = tid & 63, p = n0 + nn;
            const float* cp;
            if (kind == 0) { const int bj = (p >> 7) & 1, col = (p >> 8) * 128 + (p & 127); cp = (bj ? srcB : srcA) + col; }
            else if (kind == 1) cp = srcA + coloff + p;
            else { const int c32 = p & 31, wcw = (p >> 5) & 3, bj = (p >> 7) & 1, pn = p >> 8;
                const int d = (kind == 2) ? (32 * bj + c32) : (32 * bj + 16 * ((c32 >> 2) & 1) + 4 * (c32 >> 3) + (c32 & 3));
                cp = srcA + 64 * (4 * pn + wcw) + d; }
            const float wsc = (kind == 0) ? ((((n0 + nn) >> 7) & 1) ? -0.6931471805599453f : -LOG2E) : 1.0f;
#pragma unroll
            for (int i = 0; i < 8; ++i) { const int kk = (tid >> 6) + 8 * i; tile[kk * 65 + nn] = cp[(size_t)(k0 + kk) * ld] * wsc * (gk ? gk[k0 + kk] : 1.0f); }
            __syncthreads();
            const int nn2 = tid >> 3, ks = (tid & 7) * 8;
            float v[8];
#pragma unroll
            for (int e = 0; e < 8; ++e) v[e] = tile[(ks + e) * 65 + nn2];
            u32x4 w; w.x = pk2(v[0], v[1]); w.y = pk2(v[2], v[3]); w.z = pk2(v[4], v[5]); w.w = pk2(v[6], v[7]);
            *(u32x4*)(dst + (size_t)(n0 + nn2) * K + k0 + ks) = w;
            __syncthreads();
        }
    }
    for (int i = blockIdx.x * NTHREADS + tid; i < 1024; i += gridDim.x * NTHREADS) {
        const int pos = i >> 4, f = i & 15;
        const float freq = __builtin_amdgcn_exp2f(-(float)f * (13.287712379549449f / 16.0f));
        const float ang = (float)pos * freq;
        const float kq = rintf(ang * 0.15915494309189535f);
        float r = fmaf(-kq, 6.28318548202514648f, ang); r = fmaf(-kq, -1.74845553e-07f, r);
        ((float*)(P.ws + WS_ROPE))[i] = __cosf(r); ((float*)(P.ws + WS_ROPE))[1024 + i] = __sinf(r);
    }
}

typedef unsigned u32x2 __attribute__((ext_vector_type(2)));
struct NrRow { f32x4 h[4]; u32x4 y[2]; float ss, rms; };
__device__ __forceinline__ void nr_load(NrRow& R, const Params& P, int row, bool src_input, bool has_y, const bf16_t* h, const bf16_t* y, const float* ssqp, int lane) {
    if (src_input) {
        const float* hs = row < MREAL ? P.in[0] + (size_t)row * DM : P.in[1] + (size_t)((row - MREAL) & 15) * DM;
#pragma unroll
        for (int q = 0; q < 2; ++q) { R.h[2 * q] = *(const f32x4*)(hs + 8 * lane + 512 * q); R.h[2 * q + 1] = *(const f32x4*)(hs + 8 * lane + 512 * q + 4); }
    } else {
#pragma unroll
        for (int q = 0; q < 2; ++q) { const u32x4 w = __builtin_nontemporal_load((const u32x4*)(h + (size_t)row * DM + 8 * lane + 512 * q));
            R.h[2 * q] = (f32x4){bf_lo(w.x), bf_hi(w.x), bf_lo(w.y), bf_hi(w.y)}; R.h[2 * q + 1] = (f32x4){bf_lo(w.z), bf_hi(w.z), bf_lo(w.w), bf_hi(w.w)}; }
        R.rms = ((const float*)(P.ws + WS_RMS))[row];
    }
    if (has_y) {
#pragma unroll
        for (int q = 0; q < 2; ++q) R.y[q] = __builtin_nontemporal_load((const u32x4*)(y + (size_t)row * DM + 8 * lane + 512 * q));
        R.ss = ssqp[(size_t)row * 16 + (lane & 15)];
    }
}
__device__ __forceinline__ void nr_phase(const Params& P, bool src_input, bool has_y, bool write_h, bool final_out, float coef, const float* gpost, const float* gpre, const int tid) {
    const int wave = tid >> 6, lane = tid & 63;
    bf16_t* xn = (bf16_t*)(P.ws + WS_XN); bf16_t* h = xn; const bf16_t* y = (const bf16_t*)(P.ws + WS_Y); const float* ssqp = (const float*)(P.ws + WS_SSQ); float* rmsb = (float*)(P.ws + WS_RMS);
    f32x4 gp[4];
#pragma unroll
    for (int q = 0; q < 2; ++q) { gp[2 * q] = *(const f32x4*)(gpost + 8 * lane + 512 * q); gp[2 * q + 1] = *(const f32x4*)(gpost + 8 * lane + 512 * q + 4); }
    const int stride = gridDim.x * 8;
    int row = blockIdx.x * 8 + wave;
    NrRow nx, nx2;
    if (row < MTOK) nr_load(nx, P, row, src_input, has_y, h, y, ssqp, lane);
    if (row + stride < MTOK) nr_load(nx2, P, row + stride, src_input, has_y, h, y, ssqp, lane);
    for (; row < MTOK; row += stride) {
        NrRow cu = nx; nx = nx2;
        if (row + 2 * stride < MTOK) nr_load(nx2, P, row + 2 * stride, src_input, has_y, h, y, ssqp, lane);
        f32x4 v[4];
#pragma unroll
        for (int j = 0; j < 4; ++j) v[j] = src_input ? cu.h[j] : cu.h[j] * cu.rms;
        if (has_y) {
            float ss = cu.ss; ss += __shfl_xor(ss, 1); ss += __shfl_xor(ss, 2); ss += __shfl_xor(ss, 4); ss += __shfl_xor(ss, 8);
            const float sc = coef * rsqrtf(ss * (1.0f / DM) + EPS);
#pragma unroll
            for (int q = 0; q < 2; ++q) { const u32x4 w = cu.y[q];
                v[2 * q] += (f32x4){bf_lo(w.x), bf_hi(w.x), bf_lo(w.y), bf_hi(w.y)} * gp[2 * q] * sc;
                v[2 * q + 1] += (f32x4){bf_lo(w.z), bf_hi(w.z), bf_lo(w.w), bf_hi(w.w)} * gp[2 * q + 1] * sc; }
        }
        if (final_out) {
            if (row < MREAL) { float* o = P.out + (size_t)row * DM;
#pragma unroll
                for (int q = 0; q < 2; ++q) { *(f32x4*)(o + 8 * lane + 512 * q) = v[2 * q]; *(f32x4*)(o + 8 * lane + 512 * q + 4) = v[2 * q + 1]; } }
            continue;
        }
        float s2 = 0.f;
#pragma unroll
        for (int j = 0; j < 4; ++j) s2 += (v[j][0] * v[j][0] + v[j][1] * v[j][1]) + (v[j][2] * v[j][2] + v[j][3] * v[j][3]);
        s2 = wave_sum(s2);
        const float ms = s2 * (1.0f / DM) + EPS, r2 = rsqrtf(ms);
        if (lane == 0) rmsb[row] = ms * r2;
#pragma unroll
        for (int q = 0; q < 2; ++q) { const f32x4 a = v[2 * q] * r2, b = v[2 * q + 1] * r2; u32x4 w; w.x = pk2(a[0], a[1]); w.y = pk2(a[2], a[3]); w.z = pk2(b[0], b[1]); w.w = pk2(b[2], b[3]);
            *(u32x4*)(xn + (size_t)row * DM + 8 * lane + 512 * q) = w; }
    }
}

struct NaiveState { float m, l; float o[64]; };
__device__ __forceinline__ void naive_key(NaiveState& st, const float (&q)[64], const bf16_t* krow, const bf16_t* vcol  , float bias2) {
    float s = bias2;
#pragma unroll
    for (int c = 0; c < 8; ++c) { const u32x4 kw = *(const u32x4*)(krow + 8 * c);
        s += q[8 * c + 0] * bf_lo(kw.x) + q[8 * c + 1] * bf_hi(kw.x) + q[8 * c + 2] * bf_lo(kw.y) + q[8 * c + 3] * bf_hi(kw.y)
           + q[8 * c + 4] * bf_lo(kw.z) + q[8 * c + 5] * bf_hi(kw.z) + q[8 * c + 6] * bf_lo(kw.w) + q[8 * c + 7] * bf_hi(kw.w); }
    const float mn = fmaxf(st.m, s), corr = __builtin_amdgcn_exp2f(st.m - mn), p = __builtin_amdgcn_exp2f(s - mn);
    st.m = mn; st.l = st.l * corr + p;
#pragma unroll
    for (int d = 0; d < 64; ++d) st.o[d] = st.o[d] * corr + p * __uint_as_float((unsigned)vcol[(size_t)d * MTOK] << 16);
}
__device__ __forceinline__ void naive_load_q(float (&q)[64], const bf16_t* qp) {
#pragma unroll
    for (int c = 0; c < 8; ++c) { const u32x4 w = *(const u32x4*)(qp + 8 * c);
        q[8 * c + 0] = bf_lo(w.x); q[8 * c + 1] = bf_hi(w.x); q[8 * c + 2] = bf_lo(w.y); q[8 * c + 3] = bf_hi(w.y);
        q[8 * c + 4] = bf_lo(w.z); q[8 * c + 5] = bf_hi(w.z); q[8 * c + 6] = bf_lo(w.w); q[8 * c + 7] = bf_hi(w.w); }
}
__device__ __forceinline__ void naive_store_o(const NaiveState& st, bf16_t* op) {
    const float inv = 1.0f / st.l;
#pragma unroll
    for (int c = 0; c < 8; ++c) { u32x4 w; w.x = pk2(st.o[8 * c] * inv, st.o[8 * c + 1] * inv); w.y = pk2(st.o[8 * c + 2] * inv, st.o[8 * c + 3] * inv);
        w.z = pk2(st.o[8 * c + 4] * inv, st.o[8 * c + 5] * inv); w.w = pk2(st.o[8 * c + 6] * inv, st.o[8 * c + 7] * inv); *(u32x4*)(op + 8 * c) = w; }
}
__device__ __forceinline__ void na_attn_naive(const Params& P, const int tid) {
    const bf16_t* qk = (const bf16_t*)(P.ws + WS_BIG); const bf16_t* vt = (const bf16_t*)(P.ws + WS_VT); bf16_t* o = (bf16_t*)(P.ws + WS_H);
    const float* rpb = P.in[8]; const float* mbias = P.in[9];
    const int wave = tid >> 6, lane = tid & 63;
    for (int u = blockIdx.x * 8 + wave; u < 16384 + 256; u += gridDim.x * 8) {
        const bool meta = u >= 16384;
        int b, hd, r;
        if (!meta) { hd = u & 15; r = (u >> 4) & 63; b = u >> 10; } else { const int t = u - 16384; hd = t & 15; b = t >> 4; r = 0; }
        if (meta && lane >= 16) continue;
        const int c = lane;
        const int qrow = meta ? MREAL + b * 16 + lane : b * 4096 + r * 64 + c;
        float q[64]; naive_load_q(q, qk + (size_t)qrow * 2048 + hd * 64);
        NaiveState st; st.m = -1e30f; st.l = 0.f;
#pragma unroll
        for (int d = 0; d < 64; ++d) st.o[d] = 0.f;
        const bf16_t* vh = vt + (size_t)(hd * 64) * MTOK;
        for (int j = 0; j < 16; ++j) { const int krow = MREAL + b * 16 + j;
            naive_key(st, q, qk + (size_t)krow * 2048 + 1024 + hd * 64, vh + krow, meta ? 0.f : mbias[hd * 16 + j] * LOG2E); }
        if (!meta) {
            const int rs = min(max(r - 4, 0), 56), cs = min(max(c - 8, 0), 48);
            for (int i = 0; i < 8; ++i)
                for (int j = 0; j < 16; ++j) { const int krow = b * 4096 + (rs + i) * 64 + cs + j;
                    const float bias = rpb[(hd * 15 + (rs + i - r + 7)) * 31 + (cs + j - c + 15)];
                    naive_key(st, q, qk + (size_t)krow * 2048 + 1024 + hd * 64, vh + krow, bias * LOG2E); }
        }
        naive_store_o(st, o + (size_t)qrow * DM + hd * 64);
    }
}
__device__ __forceinline__ void gqa_attn_naive(const Params& P, const int tid) {
    const bf16_t* qk = (const bf16_t*)(P.ws + WS_BIG); const bf16_t* vt = (const bf16_t*)(P.ws + WS_VT); bf16_t* o = (bf16_t*)(P.ws + WS_H);
    const int wave = tid >> 6, lane = tid & 63;
    for (int u = blockIdx.x * 8 + wave; u < 16384 + 256; u += gridDim.x * 8) {
        const bool meta = u >= 16384;
        int b, hd, qb;
        if (!meta) { qb = u & 63; hd = (u >> 6) & 15; b = u >> 10; } else { const int t = u - 16384; hd = t & 15; b = t >> 4; qb = 0; }
        if (meta && lane >= 16) continue;
        const int kvh = hd >> 2;
        const int qrow = meta ? MREAL + b * 16 + lane : b * 4096 + qb * 64 + lane;
        float q[64]; naive_load_q(q, qk + (size_t)qrow * 1280 + hd * 64);
        NaiveState st; st.m = -1e30f; st.l = 0.f;
#pragma unroll
        for (int d = 0; d < 64; ++d) st.o[d] = 0.f;
        const bf16_t* vh = vt + (size_t)(kvh * 64) * MTOK;
        for (int j = 0; j < 4096 + 16; ++j) { const int krow = j < 4096 ? b * 4096 + j : MREAL + b * 16 + (j - 4096);
            naive_key(st, q, qk + (size_t)krow * 1280 + 1024 + kvh * 64, vh + krow, 0.f); }
        naive_store_o(st, o + (size_t)qrow * DM + hd * 64);
    }
}


typedef float f32x16 __attribute__((ext_vector_type(16)));
constexpr int ATT_ROWB = 144, ATT_KB = 64 * ATT_ROWB, ATT_BUF = 2 * ATT_KB;
template <bool FIXEDM> __device__ __forceinline__ void gqa_attn_fast(const Params& P, unsigned char* smem, const int tid, const float bnd) {
    const bf16_t* qk = (const bf16_t*)(P.ws + WS_BIG); const bf16_t* vt = (const bf16_t*)(P.ws + WS_VT); bf16_t* o = (bf16_t*)(P.ws + WS_H);
    const int wave = tid >> 6, lane = tid & 63, r = lane & 31, h = lane >> 5, qsub = wave & 3, hp = wave >> 2;
    const int G = gridDim.x, bx = blockIdx.x;
    const int skey = tid >> 3, sch = tid & 7;
    const int kapr = (r & ~12) | ((r & 4) << 1) | ((r & 8) >> 1);
    const u32x4 zero4 = {0u, 0u, 0u, 0u};
    for (int it = 0;; ++it) {
        const int ulin = it * G + bx;
        if (ulin >= 2048 + 64) break;
        const bool meta = ulin >= 2048;
        int bk, qb;
        if (meta) { bk = ulin - 2048; qb = 0; }
        else if (G == 256) { bk = it * 8 + (bx & 7); qb = bx >> 3; }
        else { bk = ulin >> 5; qb = ulin & 31; }
        const int b = bk >> 2, kvh = bk & 3;
        const int ftile = meta ? qsub : 0;
        const int qrow = meta ? MREAL + b * 16 + (r & 15) : b * 4096 + qb * 128 + qsub * 32 + r;
        bf16x8 qf[2][4];
#pragma unroll
        for (int t = 0; t < 2; ++t)
#pragma unroll
            for (int s = 0; s < 4; ++s) qf[t][s] = *(const bf16x8*)(qk + (size_t)qrow * 1280 + (kvh * 4 + hp * 2 + t) * 64 + 16 * s + 8 * h);
        f32x16 O[2][2], negm[2], L; float l[2];
        const unsigned on0 = (r < 16) ? 0x3f803f80u : 0u, on1 = (r < 16) ? 0u : 0x3f803f80u;
        const u32x4 a0_u = {on0, on0, on0, on0}, a1_u = {on1, on1, on1, on1}; const bf16x8 onesA[2] = {__builtin_bit_cast(bf16x8, a0_u), __builtin_bit_cast(bf16x8, a1_u)};
#pragma unroll
        for (int t = 0; t < 2; ++t) { l[t] = 0.f;
#pragma unroll
            for (int i = 0; i < 16; ++i) { negm[t][i] = FIXEDM ? -bnd : 0.f; L[i] = 0.f; }
#pragma unroll
            for (int dt = 0; dt < 2; ++dt)
#pragma unroll
                for (int i = 0; i < 16; ++i) O[t][dt][i] = 0.f; }
        const bf16_t* kbase = qk + 1024 + kvh * 64 + sch * 8;
        const bf16_t* vbase = vt + (size_t)(kvh * 64 + skey) * MTOK + sch * 8;
        u32x4 kr, vr;
        { const int krow0 = b * 4096;
          kr = *(const u32x4*)(kbase + (size_t)(krow0 + skey) * 1280); vr = *(const u32x4*)(vbase + krow0);
          *(u32x4*)(smem + skey * ATT_ROWB + sch * 16) = kr; *(u32x4*)(smem + ATT_KB + skey * ATT_ROWB + sch * 16) = vr; }
        __syncthreads();
        for (int tile = 0; tile <= 64; ++tile) {
            const int buf = tile & 1;
            if (tile < 64) {
                const int nt = tile + 1;
                if (nt < 64) { const int krow0 = b * 4096 + nt * 64; kr = *(const u32x4*)(kbase + (size_t)(krow0 + skey) * 1280); vr = *(const u32x4*)(vbase + krow0); }
                else { const int krow0 = MREAL + b * 16;
                    kr = skey < 16 ? *(const u32x4*)(kbase + (size_t)(krow0 + skey) * 1280) : zero4;
                    vr = sch < 2 ? *(const u32x4*)(vbase + krow0) : zero4; }
            }
            if (!meta || (tile & 3) == qsub) {
                const unsigned char* Kb = smem + buf * ATT_BUF; const unsigned char* Vb = Kb + ATT_KB;
                if (FIXEDM && tile < 64) {
#pragma unroll
                for (int sub = 0; sub < 2; ++sub) {
                    bf16x8 kf[4], vf[2][2];
#pragma unroll
                    for (int s = 0; s < 4; ++s) kf[s] = *(const bf16x8*)(Kb + (sub * 32 + kapr) * ATT_ROWB + (16 * s + 8 * h) * 2);
#pragma unroll
                    for (int dt = 0; dt < 2; ++dt)
#pragma unroll
                        for (int s2 = 0; s2 < 2; ++s2) vf[dt][s2] = *(const bf16x8*)(Vb + (dt * 32 + r) * ATT_ROWB + (sub * 32 + 16 * s2 + 8 * h) * 2);
#pragma unroll
                    for (int t = 0; t < 2; ++t) {
                        f32x16 S = __builtin_amdgcn_mfma_f32_32x32x16_bf16(kf[0], qf[t][0], negm[FIXEDM ? 0 : t], 0, 0, 0);
#pragma unroll
                        for (int s = 1; s < 4; ++s) S = __builtin_amdgcn_mfma_f32_32x32x16_bf16(kf[s], qf[t][s], S, 0, 0, 0);
                        if (tile == 64) {
#pragma unroll
                            for (int i = 8; i < 16; ++i) S[i] = -1e30f;
                        }
                        if (!FIXEDM) {
                        float mx = fmaxf(fmaxf(S[0], S[1]), S[2]);
#pragma unroll
                        for (int i = 3; i < 15; i += 2) mx = fmaxf(fmaxf(mx, S[i]), S[i + 1]);
                        mx = fmaxf(mx, S[15]);
                        mx = fmaxf(mx, __shfl_xor(mx, 32));
                        const bool first = (tile == ftile) && (sub == 0);
                        if (first || __ballot(mx > 8.0f) != 0ull) {
                            const float d = first ? mx : fmaxf(mx, 0.f), alpha = first ? 1.0f : __builtin_amdgcn_exp2f(-d);
#pragma unroll
                            for (int i = 0; i < 16; ++i) { S[i] -= d; negm[t][i] -= d; }
#pragma unroll
                            for (int i = 0; i < 8; ++i) L[8 * t + i] *= alpha;
#pragma unroll
                            for (int dt = 0; dt < 2; ++dt)
#pragma unroll
                                for (int i = 0; i < 16; ++i) O[t][dt][i] *= alpha;
                        }
                        }
#pragma unroll
                        for (int i = 0; i < 16; ++i) S[i] = __builtin_amdgcn_exp2f(S[i]);
                        bf16x8 pf[2];
#pragma unroll
                        for (int s2 = 0; s2 < 2; ++s2) { u32x4 w; w.x = pk2(S[8 * s2], S[8 * s2 + 1]); w.y = pk2(S[8 * s2 + 2], S[8 * s2 + 3]);
                            w.z = pk2(S[8 * s2 + 4], S[8 * s2 + 5]); w.w = pk2(S[8 * s2 + 6], S[8 * s2 + 7]); pf[s2] = __builtin_bit_cast(bf16x8, w); }
#pragma unroll
                        for (int dt = 0; dt < 2; ++dt)
#pragma unroll
                            for (int s2 = 0; s2 < 2; ++s2) O[t][dt] = __builtin_amdgcn_mfma_f32_32x32x16_bf16(vf[dt][s2], pf[s2], O[t][dt], 0, 0, 0);
                        L = __builtin_amdgcn_mfma_f32_32x32x16_bf16(onesA[t], pf[0], L, 0, 0, 0);
                        L = __builtin_amdgcn_mfma_f32_32x32x16_bf16(onesA[t], pf[1], L, 0, 0, 0);
                    }
                }
                } else {
                const int nsub = tile < 64 ? 2 : 1;
#pragma unroll 1
                for (int sub = 0; sub < nsub; ++sub) {
                    bf16x8 kf[4], vf[2][2];
#pragma unroll
                    for (int s = 0; s < 4; ++s) kf[s] = *(const bf16x8*)(Kb + (sub * 32 + kapr) * ATT_ROWB + (16 * s + 8 * h) * 2);
#pragma unroll
                    for (int dt = 0; dt < 2; ++dt)
#pragma unroll
                        for (int s2 = 0; s2 < 2; ++s2) vf[dt][s2] = *(const bf16x8*)(Vb + (dt * 32 + r) * ATT_ROWB + (sub * 32 + 16 * s2 + 8 * h) * 2);
#pragma unroll
                    for (int t = 0; t < 2; ++t) {
                        f32x16 S = __builtin_amdgcn_mfma_f32_32x32x16_bf16(kf[0], qf[t][0], negm[FIXEDM ? 0 : t], 0, 0, 0);
#pragma unroll
                        for (int s = 1; s < 4; ++s) S = __builtin_amdgcn_mfma_f32_32x32x16_bf16(kf[s], qf[t][s], S, 0, 0, 0);
                        if (tile == 64) {
#pragma unroll
                            for (int i = 8; i < 16; ++i) S[i] = -1e30f;
                        }
                        if (!FIXEDM) {
                        float mx = fmaxf(fmaxf(S[0], S[1]), S[2]);
#pragma unroll
                        for (int i = 3; i < 15; i += 2) mx = fmaxf(fmaxf(mx, S[i]), S[i + 1]);
                        mx = fmaxf(mx, S[15]);
                        mx = fmaxf(mx, __shfl_xor(mx, 32));
                        const bool first = (tile == ftile) && (sub == 0);
                        if (first || __ballot(mx > 8.0f) != 0ull) {
                            const float d = first ? mx : fmaxf(mx, 0.f), alpha = first ? 1.0f : __builtin_amdgcn_exp2f(-d);
#pragma unroll
                            for (int i = 0; i < 16; ++i) { S[i] -= d; negm[t][i] -= d; }
#pragma unroll
                            for (int i = 0; i < 8; ++i) L[8 * t + i] *= alpha;
#pragma unroll
                            for (int dt = 0; dt < 2; ++dt)
#pragma unroll
                                for (int i = 0; i < 16; ++i) O[t][dt][i] *= alpha;
                        }
                        }
#pragma unroll
                        for (int i = 0; i < 16; ++i) S[i] = __builtin_amdgcn_exp2f(S[i]);
                        bf16x8 pf[2];
#pragma unroll
                        for (int s2 = 0; s2 < 2; ++s2) { u32x4 w; w.x = pk2(S[8 * s2], S[8 * s2 + 1]); w.y = pk2(S[8 * s2 + 2], S[8 * s2 + 3]);
                            w.z = pk2(S[8 * s2 + 4], S[8 * s2 + 5]); w.w = pk2(S[8 * s2 + 6], S[8 * s2 + 7]); pf[s2] = __builtin_bit_cast(bf16x8, w); }
#pragma unroll
                        for (int dt = 0; dt < 2; ++dt)
#pragma unroll
                            for (int s2 = 0; s2 < 2; ++s2) O[t][dt] = __builtin_amdgcn_mfma_f32_32x32x16_bf16(vf[dt][s2], pf[s2], O[t][dt], 0, 0, 0);
                        L = __builtin_amdgcn_mfma_f32_32x32x16_bf16(onesA[t], pf[0], L, 0, 0, 0);
                        L = __builtin_amdgcn_mfma_f32_32x32x16_bf16(onesA[t], pf[1], L, 0, 0, 0);
                    }
                }
                }
}
            if (tile < 64) { const int nb = buf ^ 1;
                *(u32x4*)(smem + nb * ATT_BUF + skey * ATT_ROWB + sch * 16) = kr; *(u32x4*)(smem + nb * ATT_BUF + ATT_KB + skey * ATT_ROWB + sch * 16) = vr; }
            __syncthreads();
        }
        l[0] = L[0]; l[1] = L[8];
        if (meta) {
            if (qsub != 0) {
#pragma unroll
                for (int t = 0; t < 2; ++t) { unsigned poff = (unsigned)((((hp * 3 + qsub - 1) * 2 + t) * 34) * 64 + lane) * 4u; asm volatile("" : "+v"(poff));
                    float* p = (float*)(smem + poff);
                    p[0] = negm[t][0]; p[64] = l[t];
#pragma unroll
                    for (int dt = 0; dt < 2; ++dt)
#pragma unroll
                        for (int i = 0; i < 16; ++i) p[(2 + dt * 16 + i) * 64] = O[t][dt][i]; }
            }
            __syncthreads();
            if (qsub == 0) {
#pragma unroll
                for (int t = 0; t < 2; ++t) {
                    unsigned p0off = (unsigned)(((hp * 3 * 2 + t) * 34) * 64 + lane) * 4u; asm volatile("" : "+v"(p0off));
                    const float* p0 = (const float*)(smem + p0off);
                    const float n0 = negm[t][0], n1 = p0[0], n2 = p0[(size_t)2 * 34 * 64], n3 = p0[(size_t)4 * 34 * 64];
                    const float ns = fminf(fminf(n0, n1), fminf(n2, n3));
                    const float f0 = __builtin_amdgcn_exp2f(ns - n0);
                    l[t] *= f0;
#pragma unroll
                    for (int dt = 0; dt < 2; ++dt)
#pragma unroll
                        for (int i = 0; i < 16; ++i) O[t][dt][i] *= f0;
#pragma unroll 1
                    for (int w = 0; w < 3; ++w) { const float* p = p0 + (size_t)(w * 2 * 34) * 64; const float fw = __builtin_amdgcn_exp2f(ns - p[0]);
                        l[t] += fw * p[64];
#pragma unroll
                        for (int dt = 0; dt < 2; ++dt)
#pragma unroll
                            for (int i = 0; i < 16; ++i) O[t][dt][i] += fw * p[(2 + dt * 16 + i) * 64]; }
                }
            }
            __syncthreads();
        }
        if (!meta || (qsub == 0 && r < 16)) {
#pragma unroll
            for (int t = 0; t < 2; ++t) {
                const float lt = l[t]; const float inv = 1.0f / lt;
                bf16_t* op = o + (size_t)qrow * DM + (kvh * 4 + hp * 2 + t) * 64 + 4 * h;
#pragma unroll
                for (int dt = 0; dt < 2; ++dt)
#pragma unroll
                    for (int g = 0; g < 4; ++g) { unsigned w0 = pk2(O[t][dt][4 * g] * inv, O[t][dt][4 * g + 1] * inv), w1 = pk2(O[t][dt][4 * g + 2] * inv, O[t][dt][4 * g + 3] * inv);
                        unsigned long long w = (unsigned long long)w0 | ((unsigned long long)w1 << 32);
                        *(unsigned long long*)(op + 32 * dt + 8 * g) = w; }
            }
        }
    }
}


__device__ __forceinline__ void osm_update(f32x16& S, float& m, float& l, f32x16 (&O)[2]) {
    float mx = S[0];
#pragma unroll
    for (int i = 1; i < 16; ++i) mx = fmaxf(mx, S[i]);
    mx = fmaxf(mx, __shfl_xor(mx, 32));
    const float mn = fmaxf(m, mx), alpha = __builtin_amdgcn_exp2f(m - mn);
    m = mn;
    float rs = 0.f;
#pragma unroll
    for (int i = 0; i < 16; ++i) { S[i] = __builtin_amdgcn_exp2f(S[i] - mn); rs += S[i]; }
    l = l * alpha + rs;
#pragma unroll
    for (int dt = 0; dt < 2; ++dt)
#pragma unroll
        for (int i = 0; i < 16; ++i) O[dt][i] *= alpha;
}
__device__ __forceinline__ bf16x8 pack_p(const f32x16& S, int s2) {
    u32x4 w; w.x = pk2(S[8 * s2], S[8 * s2 + 1]); w.y = pk2(S[8 * s2 + 2], S[8 * s2 + 3]); w.z = pk2(S[8 * s2 + 4], S[8 * s2 + 5]); w.w = pk2(S[8 * s2 + 6], S[8 * s2 + 7]);
    return __builtin_bit_cast(bf16x8, w);
}
__device__ __forceinline__ void osm_lazy(f32x16& S, f32x16& negm, float& l, f32x16 (&O)[2], const bool first) {
    float mx = fmaxf(fmaxf(S[0], S[1]), S[2]);
#pragma unroll
    for (int i = 3; i < 15; i += 2) mx = fmaxf(fmaxf(mx, S[i]), S[i + 1]);
    mx = fmaxf(mx, S[15]);
    mx = fmaxf(mx, __shfl_xor(mx, 32));
    if (first || __ballot(mx > 8.0f) != 0ull) {
        const float d = first ? mx : fmaxf(mx, 0.f), alpha = first ? 1.0f : __builtin_amdgcn_exp2f(-d);
        l *= alpha;
#pragma unroll
        for (int i = 0; i < 16; ++i) { S[i] -= d; negm[i] -= d; }
#pragma unroll
        for (int dt = 0; dt < 2; ++dt)
#pragma unroll
            for (int i = 0; i < 16; ++i) O[dt][i] *= alpha;
    }
    f32x2_t rs2 = {0.f, 0.f};
#pragma unroll
    for (int i = 0; i < 16; i += 2) { S[i] = __builtin_amdgcn_exp2f(S[i]); S[i + 1] = __builtin_amdgcn_exp2f(S[i + 1]); rs2 += (f32x2_t){S[i], S[i + 1]}; }
    l += rs2.x + rs2.y;
}
__device__ __forceinline__ void osm_lazy_pair(f32x16& S0, f32x16& S1, f32x16& negm, float& l, f32x16 (&O)[2]) {
    float mx = fmaxf(fmaxf(S0[0], S0[1]), S0[2]), my = fmaxf(fmaxf(S1[0], S1[1]), S1[2]);
#pragma unroll
    for (int i = 3; i < 15; i += 2) { mx = fmaxf(fmaxf(mx, S0[i]), S0[i + 1]); my = fmaxf(fmaxf(my, S1[i]), S1[i + 1]); }
    mx = fmaxf(fmaxf(mx, S0[15]), fmaxf(my, S1[15]));
    mx = fmaxf(mx, __shfl_xor(mx, 32));
    if (__ballot(mx > 8.0f) != 0ull) {
        const float d = fmaxf(mx, 0.f), alpha = __builtin_amdgcn_exp2f(-d);
        l *= alpha;
#pragma unroll
        for (int i = 0; i < 16; ++i) { S0[i] -= d; S1[i] -= d; negm[i] -= d; }
#pragma unroll
        for (int dt = 0; dt < 2; ++dt)
#pragma unroll
            for (int i = 0; i < 16; ++i) O[dt][i] *= alpha;
    }
    float ra = 0.f, rb = 0.f, rc = 0.f, rd = 0.f;
#pragma unroll
    for (int i = 0; i < 16; i += 2) { S0[i] = __builtin_amdgcn_exp2f(S0[i]); S1[i] = __builtin_amdgcn_exp2f(S1[i]); S0[i + 1] = __builtin_amdgcn_exp2f(S0[i + 1]); S1[i + 1] = __builtin_amdgcn_exp2f(S1[i + 1]);
        ra += S0[i]; rb += S1[i]; rc += S0[i + 1]; rd += S1[i + 1]; }
    l += (ra + rb) + (rc + rd);
}
__device__ __forceinline__ void osm_lazy_pair2(f32x16& S0, f32x16& S1, f32x16& Ca, f32x16& Cb, float& l, f32x16 (&O)[2]) {
    float mx = fmaxf(fmaxf(S0[0], S0[1]), S0[2]), my = fmaxf(fmaxf(S1[0], S1[1]), S1[2]);
#pragma unroll
    for (int i = 3; i < 15; i += 2) { mx = fmaxf(fmaxf(mx, S0[i]), S0[i + 1]); my = fmaxf(fmaxf(my, S1[i]), S1[i + 1]); }
    mx = fmaxf(fmaxf(mx, S0[15]), fmaxf(my, S1[15]));
    mx = fmaxf(mx, __shfl_xor(mx, 32));
    if (__ballot(mx > 8.0f) != 0ull) {
        const float d = fmaxf(mx, 0.f), alpha = __builtin_amdgcn_exp2f(-d);
        l *= alpha;
#pragma unroll
        for (int i = 0; i < 16; ++i) { S0[i] -= d; S1[i] -= d; Ca[i] -= d; Cb[i] -= d; }
#pragma unroll
        for (int dt = 0; dt < 2; ++dt)
#pragma unroll
            for (int i = 0; i < 16; ++i) O[dt][i] *= alpha;
    }
    float ra = 0.f, rb = 0.f, rc = 0.f, rd = 0.f;
#pragma unroll
    for (int i = 0; i < 16; i += 2) { S0[i] = __builtin_amdgcn_exp2f(S0[i]); S1[i] = __builtin_amdgcn_exp2f(S1[i]); S0[i + 1] = __builtin_amdgcn_exp2f(S0[i + 1]); S1[i + 1] = __builtin_amdgcn_exp2f(S1[i + 1]);
        ra += S0[i]; rb += S1[i]; rc += S0[i + 1]; rd += S1[i + 1]; }
    l += (ra + rb) + (rc + rd);
}
__device__ __forceinline__ void osm_lazy2(f32x16& S, f32x16& Ca, f32x16& Cb, float& l, f32x16 (&O)[2], const bool first) {
    float mx = fmaxf(fmaxf(S[0], S[1]), S[2]);
#pragma unroll
    for (int i = 3; i < 15; i += 2) mx = fmaxf(fmaxf(mx, S[i]), S[i + 1]);
    mx = fmaxf(mx, S[15]);
    mx = fmaxf(mx, __shfl_xor(mx, 32));
    if (first || __ballot(mx > 8.0f) != 0ull) {
        const float d = first ? mx : fmaxf(mx, 0.f), alpha = first ? 1.0f : __builtin_amdgcn_exp2f(-d);
        l *= alpha;
#pragma unroll
        for (int i = 0; i < 16; ++i) { S[i] -= d; Ca[i] -= d; Cb[i] -= d; }
#pragma unroll
        for (int dt = 0; dt < 2; ++dt)
#pragma unroll
            for (int i = 0; i < 16; ++i) O[dt][i] *= alpha;
    }
    float ra = 0.f, rb = 0.f;
#pragma unroll
    for (int i = 0; i < 16; i += 2) { S[i] = __builtin_amdgcn_exp2f(S[i]); S[i + 1] = __builtin_amdgcn_exp2f(S[i + 1]); ra += S[i]; rb += S[i + 1]; }
    l += ra + rb;
}
constexpr int NA_TBL_OFF = 2 * ATT_BUF + 4096;
__device__ __forceinline__ void na_attn_fast(const Params& P, unsigned char* smem, const int tid) {
    const bf16_t* qk = (const bf16_t*)(P.ws + WS_BIG); const bf16_t* vt = (const bf16_t*)(P.ws + WS_VT); bf16_t* o = (bf16_t*)(P.ws + WS_H);
    const float* rpb = P.in[8]; const float* mbias = P.in[9];
    const int wave = tid >> 6, lane = tid & 63, r = lane & 31, h = lane >> 5;
    const int G = gridDim.x, bx = blockIdx.x;
    const int vb = (G % 8 == 0) ? (bx % 8) * (G / 8) + bx / 8 : bx;
    const int kapr = (r & ~12) | ((r & 4) << 1) | ((r & 8) >> 1);
    const int skey = tid >> 3, sch = tid & 7;
    float* tbl = (float*)(smem + NA_TBL_OFF);
    for (int i = tid; i < 16 * 465; i += NTHREADS) tbl[i] = rpb[i] * LOG2E;
    if (tid < 64) tbl[-64 + tid] = 0.f;
    else if (tid < 192) tbl[16 * 465 + (tid - 64)] = 0.f;
    __syncthreads();
    const int rr = wave >> 1, half = wave & 1, c = 32 * half + r, cs = min(max(c - 8, 0), 48), w0 = 8 * h - cs;
    f32x16 madd[2];
#pragma unroll
    for (int tl = 0; tl < 2; ++tl)
#pragma unroll
        for (int i = 0; i < 16; ++i) madd[tl][i] = ((unsigned)(32 * tl + 16 * (i >> 3) + (i & 7) + w0) < 16u) ? 0.f : -1e30f;
    for (int U = vb; U < 4096; U += G) {
        const int rgp = U & 15, hd = (U >> 4) & 15, b = U >> 8;
        const int R0 = 4 * rgp, rg = R0 + rr, rs = min(max(rg - 4, 0), 56);
        const int jlo = min(max(R0 - 4, 0), 56), nrows = min(max(R0 - 1, 0), 56) + 8 - jlo;
        const int qrow = b * 4096 + rg * 64 + c;
        bf16x8 qf[4];
#pragma unroll
        for (int s = 0; s < 4; ++s) qf[s] = *(const bf16x8*)(qk + (size_t)qrow * 2048 + hd * 64 + 16 * s + 8 * h);
        f32x16 O[2], cm[2], zero16; float l = 0.f;
#pragma unroll
        for (int i = 0; i < 16; ++i) { zero16[i] = 0.f; cm[0][i] = madd[0][i]; cm[1][i] = madd[1][i]; }
#pragma unroll
        for (int dt = 0; dt < 2; ++dt)
#pragma unroll
            for (int i = 0; i < 16; ++i) O[dt][i] = 0.f;
        const bf16_t* kbase = qk + 1024 + hd * 64 + sch * 8;
        const bf16_t* vbase = vt + (size_t)(hd * 64 + skey) * MTOK + sch * 8;
        u32x4 kr, vr;
        { const int krow0 = b * 4096 + jlo * 64;
          kr = *(const u32x4*)(kbase + (size_t)(krow0 + skey) * 2048); vr = *(const u32x4*)(vbase + krow0); }
        {
            const bf16_t* kp = qk + (size_t)(MREAL + b * 16 + (kapr & 15)) * 2048 + 1024 + hd * 64 + 8 * h;
            const bf16_t* vh = vt + (size_t)(hd * 64 + r) * MTOK + (MREAL + b * 16 + 8 * h);
            f32x16 S = __builtin_amdgcn_mfma_f32_32x32x16_bf16(*(const bf16x8*)(kp), qf[0], zero16, 0, 0, 0);
#pragma unroll
            for (int s = 1; s < 4; ++s) S = __builtin_amdgcn_mfma_f32_32x32x16_bf16(*(const bf16x8*)(kp + 16 * s), qf[s], S, 0, 0, 0);
            const f32x4 b0 = *(const f32x4*)(mbias + hd * 16 + 8 * h), b1 = *(const f32x4*)(mbias + hd * 16 + 8 * h + 4);
#pragma unroll
            for (int i = 0; i < 4; ++i) { S[i] += b0[i] * LOG2E; S[4 + i] += b1[i] * LOG2E; }
#pragma unroll
            for (int i = 8; i < 16; ++i) S[i] = -1e30f;
            osm_lazy2(S, cm[0], cm[1], l, O, true);
            const bf16x8 pf0 = pack_p(S, 0);
#pragma unroll
            for (int dt = 0; dt < 2; ++dt) O[dt] = __builtin_amdgcn_mfma_f32_32x32x16_bf16(*(const bf16x8*)(vh + (size_t)(dt * 32) * MTOK), pf0, O[dt], 0, 0, 0);
        }
        *(u32x4*)(smem + skey * ATT_ROWB + sch * 16) = kr; *(u32x4*)(smem + ATT_KB + skey * ATT_ROWB + sch * 16) = vr;
        __syncthreads();
        const float* tp = tbl + (hd * 465 + 8 * h - c + 15);
        for (int jj = 0; jj < nrows; ++jj) {
            const int j = jlo + jj, buf = jj & 1;
            if (jj + 1 < nrows) { const int krow0 = b * 4096 + (j + 1) * 64;
                kr = *(const u32x4*)(kbase + (size_t)(krow0 + skey) * 2048); vr = *(const u32x4*)(vbase + krow0); }
            if (j >= rs && j < rs + 8) {
                const unsigned char* Kb = smem + buf * ATT_BUF; const unsigned char* Vb = Kb + ATT_KB;
                const float* tpi = tp + 31 * (j - rg + 7);
                bf16x8 kf[2][4], vf[2][2][2];
#pragma unroll
                for (int tl = 0; tl < 2; ++tl) {
#pragma unroll
                    for (int s = 0; s < 4; ++s) kf[tl][s] = *(const bf16x8*)(Kb + (tl * 32 + kapr) * ATT_ROWB + (16 * s + 8 * h) * 2);
#pragma unroll
                    for (int dt = 0; dt < 2; ++dt)
#pragma unroll
                        for (int s2 = 0; s2 < 2; ++s2) vf[tl][dt][s2] = *(const bf16x8*)(Vb + (dt * 32 + r) * ATT_ROWB + (tl * 32 + 16 * s2 + 8 * h) * 2);
                }
                f32x16 S0 = __builtin_amdgcn_mfma_f32_32x32x16_bf16(kf[0][0], qf[0], cm[0], 0, 0, 0);
                f32x16 S1 = __builtin_amdgcn_mfma_f32_32x32x16_bf16(kf[1][0], qf[0], cm[1], 0, 0, 0);
#pragma unroll
                for (int s = 1; s < 4; ++s) { S0 = __builtin_amdgcn_mfma_f32_32x32x16_bf16(kf[0][s], qf[s], S0, 0, 0, 0); S1 = __builtin_amdgcn_mfma_f32_32x32x16_bf16(kf[1][s], qf[s], S1, 0, 0, 0); }
#pragma unroll
                for (int i = 0; i < 16; ++i) { const int kq0 = 16 * (i >> 3) + (i & 7); S0[i] += tpi[kq0]; S1[i] += tpi[32 + kq0]; }
                osm_lazy_pair2(S0, S1, cm[0], cm[1], l, O);
                { const bf16x8 p00 = pack_p(S0, 0), p01 = pack_p(S0, 1), p10 = pack_p(S1, 0), p11 = pack_p(S1, 1);
#pragma unroll
                  for (int dt = 0; dt < 2; ++dt) { O[dt] = __builtin_amdgcn_mfma_f32_32x32x16_bf16(vf[0][dt][0], p00, O[dt], 0, 0, 0);
                      O[dt] = __builtin_amdgcn_mfma_f32_32x32x16_bf16(vf[0][dt][1], p01, O[dt], 0, 0, 0);
                      O[dt] = __builtin_amdgcn_mfma_f32_32x32x16_bf16(vf[1][dt][0], p10, O[dt], 0, 0, 0);
                      O[dt] = __builtin_amdgcn_mfma_f32_32x32x16_bf16(vf[1][dt][1], p11, O[dt], 0, 0, 0); } }
            }
            if (jj + 1 < nrows) { const int nb = buf ^ 1;
                *(u32x4*)(smem + nb * ATT_BUF + skey * ATT_ROWB + sch * 16) = kr; *(u32x4*)(smem + nb * ATT_BUF + ATT_KB + skey * ATT_ROWB + sch * 16) = vr; }
            __syncthreads();
        }
        const float lt = l + __shfl_xor(l, 32), inv = 1.0f / lt;
        bf16_t* op = o + (size_t)qrow * DM + hd * 64 + 4 * h;
#pragma unroll
        for (int dt = 0; dt < 2; ++dt)
#pragma unroll
            for (int g = 0; g < 4; ++g) { const unsigned w0_ = pk2(O[dt][4 * g] * inv, O[dt][4 * g + 1] * inv), w1_ = pk2(O[dt][4 * g + 2] * inv, O[dt][4 * g + 3] * inv);
                *(unsigned long long*)(op + 32 * dt + 8 * g) = (unsigned long long)w0_ | ((unsigned long long)w1_ << 32); }
    }
    for (int u = vb * 8 + wave; u < 256; u += G * 8) {
        const int hd = u & 15, b = u >> 4;
        const int qrow = MREAL + b * 16 + (r & 15);
        f32x16 O[2], negm; float l = 0.f;
#pragma unroll
        for (int i = 0; i < 16; ++i) negm[i] = 0.f;
#pragma unroll
        for (int dt = 0; dt < 2; ++dt)
#pragma unroll
            for (int i = 0; i < 16; ++i) O[dt][i] = 0.f;
        const bf16_t* qp = qk + (size_t)qrow * 2048 + hd * 64 + 8 * h;
        const bf16_t* kp = qk + (size_t)(MREAL + b * 16 + (kapr & 15)) * 2048 + 1024 + hd * 64 + 8 * h;
        const bf16_t* vh = vt + (size_t)(hd * 64 + r) * MTOK + (MREAL + b * 16 + 8 * h);
        f32x16 S = __builtin_amdgcn_mfma_f32_32x32x16_bf16(*(const bf16x8*)(kp), *(const bf16x8*)(qp), negm, 0, 0, 0);
#pragma unroll
        for (int s = 1; s < 4; ++s) S = __builtin_amdgcn_mfma_f32_32x32x16_bf16(*(const bf16x8*)(kp + 16 * s), *(const bf16x8*)(qp + 16 * s), S, 0, 0, 0);
#pragma unroll
        for (int i = 8; i < 16; ++i) S[i] = -1e30f;
        osm_lazy(S, negm, l, O, true);
        const bf16x8 pf0 = pack_p(S, 0);
#pragma unroll
        for (int dt = 0; dt < 2; ++dt) O[dt] = __builtin_amdgcn_mfma_f32_32x32x16_bf16(*(const bf16x8*)(vh + (size_t)(dt * 32) * MTOK), pf0, O[dt], 0, 0, 0);
        const float lt = l + __shfl_xor(l, 32);
        if (r < 16) {
            const float inv = 1.0f / lt;
            bf16_t* op = o + (size_t)qrow * DM + hd * 64 + 4 * h;
#pragma unroll
            for (int dt = 0; dt < 2; ++dt)
#pragma unroll
                for (int g = 0; g < 4; ++g) { const unsigned w0_ = pk2(O[dt][4 * g] * inv, O[dt][4 * g + 1] * inv), w1_ = pk2(O[dt][4 * g + 2] * inv, O[dt][4 * g + 3] * inv);
                    *(unsigned long long*)(op + 32 * dt + 8 * g) = (unsigned long long)w0_ | ((unsigned long long)w1_ << 32); }
        }
    }
}

#define LAS __attribute__((address_space(3)))
#define XB_TMO      128
#define XB_XCNT(j)  (256  + 64 * (j))
#define XB_XSUB(j)  (1280 + 64 * (j))
#define XB_XGEN(j)  (2304 + 64 * (j))
#define XB_TOP      3328
#define XB_TOPGEN   3392
#define XCD_BAR_WORDS 3456
#define XB_SPIN_CAP (1u << 18)

__device__ __forceinline__ unsigned xb_ld(unsigned* p)              { return __hip_atomic_load(p, __ATOMIC_RELAXED, __HIP_MEMORY_SCOPE_AGENT); }
__device__ __forceinline__ unsigned xb_add(unsigned* p, unsigned v) { return __hip_atomic_fetch_add(p, v, __ATOMIC_RELAXED, __HIP_MEMORY_SCOPE_AGENT); }
__device__ __forceinline__ unsigned xb_xcc_id() { return (unsigned)__builtin_amdgcn_s_getreg((3 << 11) | 20) & 0xFu; }
#define XB_SPIN(cond, bar) do { unsigned _sp = 0; while (cond) { __builtin_amdgcn_s_sleep(1); \
    if ((++_sp & 255u) == 0u) { if (xb_ld(&(bar)[XB_TMO])) break; if (_sp > XB_SPIN_CAP) { atomicAdd(&(bar)[XB_TMO], 1u); break; } } } } while (0)

struct XcdBarrier {
    unsigned* bar; unsigned x;
    volatile LAS unsigned* st;
};

__device__ __forceinline__ XcdBarrier xcd_barrier_post(unsigned* bar, volatile LAS unsigned* st) {
    XcdBarrier b; b.bar = bar; b.x = xb_xcc_id(); b.st = st;
    if (threadIdx.x == 0) (void)xb_add(&bar[XB_XCNT(b.x)], 1u);
    return b;
}
__device__ __forceinline__ void xcd_barrier_complete(unsigned* bar, unsigned x, unsigned& nloc, unsigned& nx) {
    const unsigned G = gridDim.x * gridDim.y * gridDim.z;
    unsigned sum, cnt, mine, sp = 0u;
    for (;;) {
        sum = 0u; cnt = 0u; mine = 0u;
#pragma unroll
        for (unsigned j = 0; j < 16; ++j) { const unsigned c = xb_ld(&bar[XB_XCNT(j)]); sum += c; cnt += (c > 0u) ? 1u : 0u; mine = (j == x) ? c : mine; }
        if (sum == G) break;
        __builtin_amdgcn_s_sleep(1);
        if ((++sp & 255u) == 0u) { if (xb_ld(&bar[XB_TMO])) break; if (sp > XB_SPIN_CAP) { atomicAdd(&bar[XB_TMO], 1u); break; } }
    }
    nloc = mine > 0u ? mine : 1u; nx = cnt > 0u ? cnt : 1u;
}

__device__ __forceinline__ void xcd_barrier(const XcdBarrier& b) {
    asm volatile("s_waitcnt vmcnt(0)" ::: "memory");
    __syncthreads();
    if (threadIdx.x == 0) {
        unsigned* bar = b.bar;
        __builtin_amdgcn_s_waitcnt(0);
        unsigned nloc = b.st[0], nx = b.st[1];
        if (nloc == 0u) { xcd_barrier_complete(bar, b.x, nloc, nx); b.st[0] = nloc; b.st[1] = nx; }
        const unsigned old = xb_add(&bar[XB_XSUB(b.x)], 1u);
        const unsigned gen = old / nloc;
        if (old + 1u == (gen + 1u) * nloc) {
            __builtin_amdgcn_fence(__ATOMIC_RELEASE, "agent");
            asm volatile("s_waitcnt vmcnt(0)" ::: "memory");
            const unsigned og = xb_add(&bar[XB_TOP], 1u);
            const unsigned tg = og / nx;
            if (og + 1u == (tg + 1u) * nx) xb_add(&bar[XB_TOPGEN], 1u);
            else XB_SPIN(xb_ld(&bar[XB_TOPGEN]) == tg, bar);
            __builtin_amdgcn_fence(__ATOMIC_ACQUIRE, "agent");
            xb_add(&bar[XB_XGEN(b.x)], 1u);
            asm volatile("s_waitcnt vmcnt(0)" ::: "memory");
        } else {
            XB_SPIN(xb_ld(&bar[XB_XGEN(b.x)]) == gen, bar);
            __builtin_amdgcn_fence(__ATOMIC_ACQUIRE, "agent");
            asm volatile("s_waitcnt vmcnt(0)" ::: "memory");
        }
    }
    __syncthreads();
}

#if MK_ONE_LAUNCH
#define GRID_SYNC() do { XcdBarrier xb_; xb_.bar = (unsigned*)P.ws; xb_.x = xb_xcc_id(); xb_.st = (volatile LAS unsigned*)(lds + XB_LDS_OFF); xcd_barrier(xb_); } while (0)
#else
#define GRID_SYNC() do {} while (0)
#endif
constexpr int XB_LDS_OFF = 131072;
constexpr size_t XB_WS_BYTES = 16384;
constexpr int N_PHASES = 21;
__global__ void __launch_bounds__(NTHREADS, 2) mk_fwd(Params P) {
    extern __shared__ __attribute__((aligned(16))) unsigned char smem[];
    PG8_LAS unsigned char* lds = (PG8_LAS unsigned char*)smem;
    const int G = gridDim.x, bx = blockIdx.x;
#if MK_ONE_LAUNCH
    if (threadIdx.x == 0) { ((volatile LAS unsigned*)(lds + XB_LDS_OFF))[0] = 0u; ((volatile LAS unsigned*)(lds + XB_LDS_OFF))[1] = 0u; }
    if (blockIdx.x == 0) for (int i = threadIdx.x; i < XCD_BAR_WORDS; i += NTHREADS) ((unsigned*)P.ws)[i] = 0u;
    __syncthreads();
#endif
    if (P.ph_lo == 0) {
        int tid = threadIdx.x; asm volatile("" : "+v"(tid));
        p0_weights(P, smem, tid);
        nr_phase(P, true, false, false, false, 0.f, P.in[2], P.in[2], tid);
#if MK_ONE_LAUNCH
        if (1 < P.ph_hi) cg::this_grid().sync();
        (void)xcd_barrier_post((unsigned*)P.ws, (volatile LAS unsigned*)(lds + XB_LDS_OFF));
#endif
    }
    for (int ph = (P.ph_lo == 0 ? 1 : P.ph_lo); ph < P.ph_hi; ++ph) {
        int tid = threadIdx.x; asm volatile("" : "+v"(tid));
        unsigned char* ws = P.ws; asm volatile("" : "+s"(ws));
        unsigned char* W = ws + WS_W;
        bf16_t* xn = (bf16_t*)(ws + WS_XN); bf16_t* yb = (bf16_t*)(ws + WS_Y); bf16_t* big = (bf16_t*)(ws + WS_BIG); bf16_t* vt = (bf16_t*)(ws + WS_VT);
        float* ssqp = (float*)(ws + WS_SSQ);
        const float* gains = P.in[2];
        {
            const int l = (ph - 1) / 10, s = (ph - 1) % 10;
            const float* gl = gains + (size_t)l * 6 * DM;
            if (s == 0 || s == 7) {
                const int lj = l * 2 + (s == 7);
                pg8::Gemm g{xn, (const bf16_t*)(W + lj * W_FFN_BYTES), MTOK, 2 * FF, DM}; pg8::StaticOrder S; S.init(MTOK, 2 * FF, G, bx);
                EpiSwiGLU E{big};
                pg8::gemm_phase<EpiSwiGLU, pg8::StaticOrder, true, true>(lds, g, S, E, tid);
            } else if (s == 1 || s == 5 || s == 8) {
                pg8::Gemm g; g.M = MREAL; g.N = DM;
                if (s == 5) { g.A = (const bf16_t*)(ws + WS_H); g.Bt = (const bf16_t*)(W + (l == 0 ? W_NA_O : W_GQA_O)); g.K = DM; }
                else { g.A = big; g.Bt = (const bf16_t*)(W + (l * 2 + (s == 8)) * W_FFN_BYTES + W_GU_BYTES); g.K = FF; }
                pg8::StaticOrder S; S.init(MREAL, DM, G, bx);
                EpiY E{yb, ssqp};
                pg8::gemm_phase<EpiY, pg8::StaticOrder, true, true>(lds, g, S, E, tid);
                { int tid2 = threadIdx.x; asm volatile("" : "+v"(tid2));
                  meta_gemm_y(g.A, g.Bt, g.K, yb, ssqp, smem, tid2); }
            } else if (s == 2) nr_phase(P, l == 0, true, true, false, 0.5f, gl + 1 * DM, gl + 2 * DM, tid);
            else if (s == 6) nr_phase(P, false, true, true, false, 1.0f, gl + 3 * DM, gl + 4 * DM, tid);
            else if (s == 9) nr_phase(P, false, true, true, l == 1, 0.5f, gl + 5 * DM, gains + (size_t)((l + 1) % 2) * 6 * DM, tid);
            else if (s == 3) {
                const float* rc = (const float*)(ws + WS_ROPE);
                if (l == 0) {
                    pg8::Gemm g{xn, (const bf16_t*)(W + W_NA_QK), MTOK, 2048, DM}; pg8::StaticOrder S; S.init(MTOK, 2048, G, bx);
                    EpiQK<false> E{big, 2048, 0.125f * LOG2E, nullptr, nullptr, nullptr, nullptr};
                    pg8::gemm_phase<EpiQK<false>, pg8::StaticOrder, true, true>(lds, g, S, E, tid);
                } else {
                    pg8::Gemm g{xn, (const bf16_t*)(W + W_GQA_QK), MTOK, 1280, DM}; pg8::StaticOrder S; S.init(MTOK, 1280, G, bx);
                    EpiQK<true> E{big, 1280, 0.125f * LOG2E, P.in[12], P.in[13], rc, rc + 1024};
                    pg8::gemm_phase<EpiQK<true>, pg8::StaticOrder, true, true>(lds, g, S, E, tid);
                }
                { const int mv = (l == 0) ? 1024 : 256;
                  int tid = threadIdx.x; asm volatile("" : "+v"(tid));
                  pg8::Gemm g{(const bf16_t*)(W + (l == 0 ? W_NA_V : W_GQA_V)), xn, mv, MTOK, DM}; pg8::StaticOrder S; S.init(mv, MTOK, G, bx);
                  EpiPlain E{vt, (size_t)MTOK};
                  pg8::gemm_phase<EpiPlain, pg8::StaticOrder, true, true>(lds, g, S, E, tid); }
            } else {

#ifndef NO_ATTN
                if (l == 0) {
#if NA_FAST
                    na_attn_fast(P, smem, tid);
#else
                    na_attn_naive(P, tid);
#endif
                } else {
#if GQA_FAST
                    {
                        const int ln = tid & 63;
                        float gq = fabsf(P.in[12][ln]), gk = fabsf(P.in[13][ln]);
#pragma unroll
                        for (int o = 32; o >= 1; o >>= 1) { gq = fmaxf(gq, __shfl_xor(gq, o)); gk = fmaxf(gk, __shfl_xor(gk, o)); }
                        const float bnd = 8.0f * LOG2E * gq * gk * 1.02f + 0.5f;
                        if (bnd < 50.0f) gqa_attn_fast<true>(P, smem, tid, bnd); else gqa_attn_fast<false>(P, smem, tid, 0.f);
                    }
#else
                    gqa_attn_naive(P, tid);
#endif
                }
#endif

            }
        }
        if (ph + 1 < P.ph_hi) GRID_SYNC();
    }
}

extern "C" void kernel_launch(void* const* d_in, const int* in_sizes, int n_in, void* d_out, int out_size, void* d_ws, size_t ws_size, hipStream_t stream) {
    static int grid = 0;
    if (grid == 0) {
        if (n_in != 14 || out_size != MREAL * DM || ws_size < WS_END) { fprintf(stderr, "kernel_launch: unexpected shapes (n_in %d out %d ws %zu)\n", n_in, out_size, ws_size); grid = -1; return; }
        int dev = 0, cus = 0, per_cu = 0;
        hipGetDevice(&dev); hipDeviceGetAttribute(&cus, hipDeviceAttributeMultiprocessorCount, dev);
        if (hipFuncSetAttribute((const void*)mk_fwd, hipFuncAttributeMaxDynamicSharedMemorySize, LDS_BYTES) != hipSuccess) { fprintf(stderr, "kernel_launch: hipFuncSetAttribute failed\n"); grid = -1; return; }
        if (hipOccupancyMaxActiveBlocksPerMultiprocessor(&per_cu, (const void*)mk_fwd, NTHREADS, LDS_BYTES) != hipSuccess || per_cu < 1) { fprintf(stderr, "kernel_launch: occupancy query gave %d\n", per_cu); per_cu = 1; }
        (void)hipGetLastError();
        grid = cus * per_cu;
    }
    if (grid < 0) return;
    Params p{};
    for (int i = 0; i < 14; ++i) p.in[i] = (const float*)d_in[i];
    p.out = (float*)d_out; p.ws = (unsigned char*)d_ws;
#if MK_ONE_LAUNCH
    p.ph_lo = 0; p.ph_hi = N_PHASES;
    void* args[] = {&p};
    hipError_t e = hipLaunchCooperativeKernel((const void*)mk_fwd, dim3(grid), dim3(NTHREADS), args, LDS_BYTES, stream);
    if (e != hipSuccess) fprintf(stderr, "cooperative launch failed: %s (grid %d)\n", hipGetErrorString(e), grid);
#else
    for (int ph = 0; ph < N_PHASES; ++ph) {
        p.ph_lo = ph; p.ph_hi = ph + 1;
        for (int rep = 0; rep < (int)((DUP_MASK >> ph) & 1u) + 1; ++rep)
            hipLaunchKernelGGL(mk_fwd, dim3(grid), dim3(NTHREADS), LDS_BYTES, stream, p);
    }
#endif
}
```

```cpp
#include <hip/hip_runtime.h>
#include <hip/hip_cooperative_groups.h>
#include <cstdio>
#include <cstdint>
namespace cg = cooperative_groups;
#ifndef MK_ONE_LAUNCH
#define MK_ONE_LAUNCH 1
#endif
#ifndef NA_FAST
#define NA_FAST 1
#endif
#ifndef GQA_FAST
#define GQA_FAST 1
#endif
#ifndef DUP_MASK
#define DUP_MASK 0u
#endif
#ifndef DUP_VARIANT
#define DUP_VARIANT 0
#endif
namespace pg8 {
#define PG8_LAS __attribute__((address_space(3)))
typedef unsigned short bf16_t;
typedef short bf16x8 __attribute__((ext_vector_type(8)));
typedef float f32x4 __attribute__((ext_vector_type(4)));
typedef unsigned u32x4 __attribute__((ext_vector_type(4)));
constexpr int BM = 256, BK = 64, HALF = 128, HTB = HALF * BK * 2  , STAGE_BYTES = 8 * HTB, NXCD = 8, WGM = 8;

__host__ __device__ __forceinline__ int lds_byte(int r, int c) { const int st = (r >> 4) * 2 + (c >> 5), rr = r & 15, cc = c & 31, ob = rr * 64 + cc * 2; return st * 1024 + (ob ^ (((ob >> 9) & 1) << 5)); }
__host__ __device__ __forceinline__ void stage_rc(int b, int& R, int& C) { const int st = b / 1024, sb = b % 1024, swz = sb ^ (((sb >> 9) & 1) << 5); R = (st >> 1) * 16 + swz / 64; C = (st & 1) * 32 + (swz % 64) / 2; }
__host__ __device__ __forceinline__ int perm32(int rho) { const int n = rho >> 4, i = rho & 15; return 8 * (i >> 2) + 4 * n + (i & 3); }

struct Unit { int pm, pn; };
struct Gemm { const bf16_t* A; const bf16_t* Bt; int M, N, K; };

struct StaticOrder {
    int nM, nN, nwg, G, c;
    __host__ __device__ void init(int M, int N, int G_, int c_) { nM = M / BM; nN = N / BM; nwg = nM * nN; G = G_; c = c_; }
    __host__ __device__ bool next(int i, Unit& u) const {
        const long L = (long)i * G + c; if (L >= nwg) return false;
        int wgid = (int)L; { const int q = nwg / NXCD, r = nwg % NXCD, xcd = wgid % NXCD, off = wgid / NXCD; wgid = (xcd < r ? xcd * (q + 1) : r * (q + 1) + (xcd - r) * q) + off; }
        const int nig = WGM * nN, gid = wgid / nig, fm = gid * WGM, gsz = (nM - fm) < WGM ? (nM - fm) : WGM;
        u.pm = fm + ((wgid % nig) % gsz); u.pn = (wgid % nig) / gsz; return true;
    }
    __device__ __forceinline__ void a_ready(const Unit&) const {}
    __device__ __forceinline__ void done(const Unit&) const {}
};

__device__ __forceinline__ unsigned cvt_pk_bf16(float lo, float hi) { unsigned r; asm volatile("v_cvt_pk_bf16_f32 %0, %1, %2" : "=v"(r) : "v"(lo), "v"(hi)); return r; }
template <class Epi, class Sched, bool ALIGN_EPI = false, bool SP2 = false>
__device__ __forceinline__ void gemm_phase(PG8_LAS unsigned char* lds, const Gemm g, const Sched& S, const Epi& E, const int tid) {
    const int wid = __builtin_amdgcn_readfirstlane(tid >> 6), lane = tid & 63, wr = wid >> 2, wc = wid & 3, fr = lane & 15, fq = lane >> 4;
    const int K = g.K, nt = K / BK;
    unsigned voffA[2], voffB[2];
#pragma unroll
    for (int i = 0; i < 2; ++i) { int R, C; stage_rc(tid * 16 + i * 8192, R, C); const int Rb = Epi::PERM ? ((R & ~31) + perm32(R & 31)) : R;
        voffA[i] = (unsigned)(R * K + C) * 2u; voffB[i] = (unsigned)(Rb * K + C) * 2u; }
    const size_t kstep = (size_t)(BK * 2);
    const size_t hstep = (size_t)HALF * K * 2;
    const size_t tstep = 2 * hstep;
    const unsigned ldsw = (unsigned)wid * 1024u;
    const int aoff = lds_byte(wr * 64 + fr, fq * 8), boff = lds_byte(wc * 32 + fr, fq * 8);
#define PG8_SA(b, h) (((b) * 2 + (h)) * HTB)
#define PG8_SB(b, h) ((4 + (b) * 2 + (h)) * HTB)
#define PG8_STAGE(bufoff, gbase, voff) do { _Pragma("unroll") for (int _i = 0; _i < 2; ++_i) \
        __builtin_amdgcn_global_load_lds((const unsigned*)((const char*)(gbase) + (voff)[_i]), (PG8_LAS unsigned*)(lds + (bufoff) + ldsw + _i * 8192), 16, 0, 0); } while (0)
#define PG8_LDA(dst, b, h) do { _Pragma("unroll") for (int m = 0; m < 4; ++m) _Pragma("unroll") for (int k = 0; k < 2; ++k) dst[m][k] = *(const PG8_LAS bf16x8*)(lds + PG8_SA(b, h) + aoff + m * 2048 + k * 1024); } while (0)
#define PG8_LDB(dst, b, h) do { _Pragma("unroll") for (int n = 0; n < 2; ++n) _Pragma("unroll") for (int k = 0; k < 2; ++k) dst[n][k] = *(const PG8_LAS bf16x8*)(lds + PG8_SB(b, h) + boff + n * 2048 + k * 1024); } while (0)
#define PG8_MMA(ai, bj, At, Bt) do { __builtin_amdgcn_s_setprio(1); _Pragma("unroll") for (int m = 0; m < 4; ++m) _Pragma("unroll") for (int n = 0; n < 2; ++n) _Pragma("unroll") for (int k = 0; k < 2; ++k) \
        acc[ai][bj][m][n] = __builtin_amdgcn_mfma_f32_16x16x32_bf16(Bt[n][k], At[m][k], acc[ai][bj][m][n], 0, 0, 0); __builtin_amdgcn_s_setprio(0); } while (0)
#define PG8_WAIT_V(n) asm volatile("s_waitcnt vmcnt(" #n ")" ::: "memory")
#define PG8_WAIT_L(n) asm volatile("s_waitcnt lgkmcnt(" #n ")" ::: "memory")
#define PG8_BAR __builtin_amdgcn_s_barrier()
#define PG8_SCHED __builtin_amdgcn_sched_barrier(0)
    Unit cur, nxt; int ui = 0;
    if (!S.next(0, cur)) return;
    f32x4 acc[2][2][4][2];
#pragma unroll
    for (int a = 0; a < 2; ++a)
#pragma unroll
        for (int b = 0; b < 2; ++b)
#pragma unroll
            for (int m = 0; m < 4; ++m)
#pragma unroll
                for (int n = 0; n < 2; ++n) acc[a][b][m][n] = (f32x4){0.f, 0.f, 0.f, 0.f};
    bf16x8 At[4][2], B0[2][2], B1[2][2];
    const char* cA = (const char*)g.A + (size_t)cur.pm * tstep; const char* cB = (const char*)g.Bt + (size_t)cur.pn * tstep;
    S.a_ready(cur);
    if constexpr (SP2) {
        PG8_STAGE(PG8_SB(0, 0), cB, voffB); PG8_STAGE(PG8_SB(0, 1), cB + hstep, voffB); PG8_STAGE(PG8_SA(0, 0), cA, voffA); PG8_STAGE(PG8_SA(0, 1), cA + hstep, voffA);
        if (wr == 1) PG8_BAR;
        PG8_WAIT_V(2); PG8_BAR;
        PG8_STAGE(PG8_SB(1, 0), cB + kstep, voffB); PG8_STAGE(PG8_SA(1, 0), cA + kstep, voffA); PG8_STAGE(PG8_SB(1, 1), cB + hstep + kstep, voffB);
        PG8_WAIT_V(6); PG8_BAR;
    } else {
        PG8_STAGE(PG8_SB(0, 0), cB, voffB); PG8_STAGE(PG8_SA(0, 0), cA, voffA); PG8_STAGE(PG8_SB(0, 1), cB + hstep, voffB); PG8_STAGE(PG8_SA(0, 1), cA + hstep, voffA);
        if (wr == 1) PG8_BAR;
        PG8_WAIT_V(4); PG8_BAR;
        PG8_STAGE(PG8_SB(1, 0), cB + kstep, voffB); PG8_STAGE(PG8_SA(1, 0), cA + kstep, voffA); PG8_STAGE(PG8_SB(1, 1), cB + hstep + kstep, voffB);
        PG8_WAIT_V(6); PG8_BAR;
    }
    for (;;) {
        const bool has_next = S.next(ui + 1, nxt);
        const char* nA = has_next ? (const char*)g.A + (size_t)nxt.pm * tstep : cA; const char* nB = has_next ? (const char*)g.Bt + (size_t)nxt.pn * tstep : cB;
        for (int t = 0; t < nt; t += 2) {
            const bool last = (t == nt - 2);
            const char* a1 = cA + (size_t)(t + 1) * kstep;
            const char* a2 = last ? nA : cA + (size_t)(t + 2) * kstep; const char* b2 = last ? nB : cB + (size_t)(t + 2) * kstep;
            const char* a3 = a2 + kstep; const char* b3 = b2 + kstep;
            if (last && has_next) S.a_ready(nxt);
            if constexpr (SP2) {
            PG8_LDB(B0, 0, 0); PG8_LDB(B1, 0, 1); PG8_SCHED; PG8_LDA(At, 0, 0); PG8_STAGE(PG8_SA(1, 1), a1 + hstep, voffA);
            PG8_WAIT_V(8); PG8_WAIT_L(0); PG8_BAR; PG8_MMA(0, 0, At, B0); PG8_MMA(0, 1, At, B1); PG8_BAR; PG8_SCHED;
            PG8_LDA(At, 0, 1); PG8_STAGE(PG8_SB(0, 0), b2, voffB); PG8_STAGE(PG8_SB(0, 1), b2 + hstep, voffB); PG8_STAGE(PG8_SA(0, 0), a2, voffA);
            PG8_WAIT_V(8); PG8_WAIT_L(0); PG8_BAR; PG8_MMA(1, 0, At, B0); PG8_MMA(1, 1, At, B1); PG8_BAR; PG8_SCHED;
            PG8_LDB(B0, 1, 0); PG8_LDB(B1, 1, 1); PG8_SCHED; PG8_LDA(At, 1, 0); PG8_STAGE(PG8_SA(0, 1), a2 + hstep, voffA);
            PG8_WAIT_V(8); PG8_WAIT_L(0); PG8_BAR; PG8_MMA(0, 0, At, B0); PG8_MMA(0, 1, At, B1); PG8_BAR; PG8_SCHED;
            PG8_LDA(At, 1, 1); PG8_STAGE(PG8_SB(1, 0), b3, voffB); PG8_STAGE(PG8_SB(1, 1), b3 + hstep, voffB); PG8_STAGE(PG8_SA(1, 0), a3, voffA);
            PG8_WAIT_V(8); PG8_WAIT_L(0); PG8_BAR; PG8_MMA(1, 0, At, B0); PG8_MMA(1, 1, At, B1); PG8_BAR; PG8_SCHED;
            } else {
            PG8_LDB(B0, 0, 0); PG8_SCHED; PG8_LDA(At, 0, 0); PG8_STAGE(PG8_SA(1, 1), a1 + hstep, voffA);
            PG8_WAIT_L(8); PG8_BAR; PG8_WAIT_L(0); PG8_MMA(0, 0, At, B0); PG8_BAR; PG8_SCHED;
            PG8_LDB(B1, 0, 1); PG8_STAGE(PG8_SB(0, 0), b2, voffB);
            PG8_BAR; PG8_WAIT_L(0); PG8_MMA(0, 1, At, B1); PG8_BAR;
            PG8_LDA(At, 0, 1); PG8_STAGE(PG8_SA(0, 0), a2, voffA);
            PG8_BAR; PG8_WAIT_L(0); PG8_MMA(1, 0, At, B0); PG8_BAR; PG8_SCHED;
            PG8_STAGE(PG8_SB(0, 1), b2 + hstep, voffB);
            PG8_WAIT_V(6); PG8_BAR; PG8_MMA(1, 1, At, B1); PG8_BAR;
            PG8_LDB(B0, 1, 0); PG8_SCHED; PG8_LDA(At, 1, 0); PG8_STAGE(PG8_SA(0, 1), a2 + hstep, voffA);
            PG8_WAIT_L(8); PG8_BAR; PG8_WAIT_L(0); PG8_MMA(0, 0, At, B0); PG8_BAR; PG8_SCHED;
            PG8_LDB(B1, 1, 1); PG8_STAGE(PG8_SB(1, 0), b3, voffB);
            PG8_BAR; PG8_WAIT_L(0); PG8_MMA(0, 1, At, B1); PG8_BAR;
            PG8_LDA(At, 1, 1); PG8_STAGE(PG8_SA(1, 0), a3, voffA);
            PG8_BAR; PG8_WAIT_L(0); PG8_MMA(1, 0, At, B0); PG8_BAR; PG8_SCHED;
            PG8_STAGE(PG8_SB(1, 1), b3 + hstep, voffB);
            PG8_WAIT_V(6); PG8_BAR; PG8_MMA(1, 1, At, B1); PG8_BAR;
            }
        }
        if constexpr (ALIGN_EPI) { if (wr == 0) PG8_BAR; }
        if constexpr (!Epi::AFTER_DRAIN) { E(acc, cur, wr, wc, fr, fq); S.done(cur); }
        if (!has_next) break;
#pragma unroll
        for (int a = 0; a < 2; ++a)
#pragma unroll
            for (int b = 0; b < 2; ++b)
#pragma unroll
                for (int m = 0; m < 4; ++m)
#pragma unroll
                    for (int n = 0; n < 2; ++n) acc[a][b][m][n] = (f32x4){0.f, 0.f, 0.f, 0.f};
        cur = nxt; cA = nA; cB = nB; ++ui;
        if constexpr (ALIGN_EPI) { if (wr == 1) PG8_BAR; }
    }
    PG8_WAIT_V(0);
    if constexpr (!ALIGN_EPI) { if (wr == 0) PG8_BAR; }
    PG8_BAR;
    if constexpr (Epi::AFTER_DRAIN) { E.fused(acc, cur, wr, wc, fr, fq, lds, wid, lane); S.done(cur); }
#undef PG8_SA
#undef PG8_SB
#undef PG8_STAGE
#undef PG8_LDA
#undef PG8_LDB
#undef PG8_MMA
#undef PG8_WAIT_V
#undef PG8_WAIT_L
#undef PG8_BAR
#undef PG8_SCHED
}
}

using pg8::bf16_t; using pg8::bf16x8; using pg8::f32x4; using pg8::u32x4; using pg8::Unit;
constexpr int DM = 1024, NB = 16, SEQ = 4096, NMETA = 16, MREAL = NB * SEQ  , MTOK = MREAL + NB * NMETA  ;
constexpr int FF = 2816, NH = 16, HD = 64;
constexpr float EPS = 1e-6f, LOG2E = 1.4426950408889634f;

constexpr size_t MiB = 1u << 20;
constexpr size_t WS_ROPE = 512 * 1024;
constexpr size_t WS_SSQ = 1 * MiB;
constexpr size_t WS_RMS = 6 * MiB;
constexpr size_t WS_W = 8 * MiB;
constexpr size_t W_GU_BYTES = (size_t)2 * FF * DM * 2, W_DN_BYTES = (size_t)DM * FF * 2, W_FFN_BYTES = W_GU_BYTES + W_DN_BYTES;
constexpr size_t W_NA = 4 * W_FFN_BYTES, W_NA_QK = W_NA, W_NA_V = W_NA + (size_t)2048 * DM * 2, W_NA_O = W_NA_V + (size_t)DM * DM * 2;
constexpr size_t W_GQA = W_NA_O + (size_t)DM * DM * 2, W_GQA_QK = W_GQA, W_GQA_V = W_GQA + (size_t)1280 * DM * 2, W_GQA_O = W_GQA_V + (size_t)256 * DM * 2;
constexpr size_t W_END = W_GQA_O + (size_t)DM * DM * 2;
static_assert(W_END <= 88 * MiB, "weights region");
constexpr size_t WS_H = 96 * MiB;
constexpr size_t WS_XN = 353 * MiB;
constexpr size_t WS_Y = 482 * MiB;
constexpr size_t WS_BIG = 611 * MiB;
constexpr size_t WS_VT = WS_BIG + (size_t)MTOK * 2048 * 2;
constexpr size_t WS_END = WS_VT + (size_t)DM * MTOK * 2;
static_assert(WS_END <= 1024 * MiB && WS_BIG + (size_t)MTOK * FF * 2 <= 1024 * MiB, "workspace");
static_assert(WS_H + (size_t)MTOK * DM * 4 <= WS_XN && WS_XN + (size_t)MTOK * DM * 2 <= WS_Y && WS_Y + (size_t)MTOK * DM * 2 <= WS_BIG, "workspace map");

constexpr int LDS_BYTES = 135168;
constexpr int NTHREADS = 512;

struct Params { const float* in[14]; float* out; unsigned char* ws; int ph_lo, ph_hi; };

typedef float f32x2_t __attribute__((ext_vector_type(2)));
typedef __bf16 bf16x2_t __attribute__((ext_vector_type(2)));
__device__ __forceinline__ unsigned pk2(float lo, float hi) { const f32x2_t v = {lo, hi}; const bf16x2_t b = __builtin_convertvector(v, bf16x2_t); return __builtin_bit_cast(unsigned, b); }
__device__ __forceinline__ float bf_lo(unsigned w) { return __uint_as_float(w << 16); }
__device__ __forceinline__ float bf_hi(unsigned w) { return __uint_as_float(w & 0xffff0000u); }
__device__ __forceinline__ float wave_sum(float v) {
#pragma unroll
    for (int o = 32; o >= 1; o >>= 1) v += __shfl_xor(v, o);
    return v;
}

struct EpiSwiGLU {
    static constexpr bool PERM = true, AFTER_DRAIN = false;
    bf16_t* O;
    __device__ __forceinline__ void operator()(const f32x4 (&acc)[2][2][4][2], const Unit& u, int wr, int wc, int fr, int fq) const {
        const int row0 = u.pm * 256 + wr * 64 + fr, col0 = u.pn * 128 + wc * 32 + 8 * fq;
#pragma unroll
        for (int ai = 0; ai < 2; ++ai)
#pragma unroll
            for (int m = 0; m < 4; ++m) {
                bf16_t* p = O + (size_t)(row0 + ai * 128 + m * 16) * FF + col0;
                float h[8];
#pragma unroll
                for (int n = 0; n < 2; ++n)
#pragma unroll
                    for (int e = 0; e < 4; ++e) { const float gneg = acc[ai][0][m][n][e], ups = acc[ai][1][m][n][e];
                        h[n * 4 + e] = gneg * ups * __builtin_amdgcn_rcpf(1.0f + __builtin_amdgcn_exp2f(gneg)); }
                u32x4 w; w.x = pk2(h[0], h[1]); w.y = pk2(h[2], h[3]); w.z = pk2(h[4], h[5]); w.w = pk2(h[6], h[7]);
                *(u32x4*)p = w;
            }
    }
};
struct EpiY {
    static constexpr bool PERM = true, AFTER_DRAIN = false;
    bf16_t* Y; float* ssqp;
    __device__ __forceinline__ void operator()(const f32x4 (&acc)[2][2][4][2], const Unit& u, int wr, int wc, int fr, int fq) const {
        const int row0 = u.pm * 256 + wr * 64 + fr, col0 = u.pn * 256 + wc * 32 + 8 * fq;
#pragma unroll
        for (int ai = 0; ai < 2; ++ai)
#pragma unroll
            for (int m = 0; m < 4; ++m) {
                const int row = row0 + ai * 128 + m * 16; float s = 0.f;
#pragma unroll
                for (int bj = 0; bj < 2; ++bj) { const f32x4 v0 = acc[ai][bj][m][0], v1 = acc[ai][bj][m][1];
                    s += (v0[0] * v0[0] + v0[1] * v0[1]) + (v0[2] * v0[2] + v0[3] * v0[3]) + (v1[0] * v1[0] + v1[1] * v1[1]) + (v1[2] * v1[2] + v1[3] * v1[3]);
                    u32x4 w; w.x = pk2(v0[0], v0[1]); w.y = pk2(v0[2], v0[3]); w.z = pk2(v1[0], v1[1]); w.w = pk2(v1[2], v1[3]);
                    *(u32x4*)(Y + (size_t)row * DM + col0 + bj * 128) = w; }
                s += __shfl_xor(s, 16); s += __shfl_xor(s, 32);
                if (fq == 0) ssqp[(size_t)row * 16 + u.pn * 4 + wc] = s;
            }
    }
};
struct EpiPlain {
    static constexpr bool PERM = true, AFTER_DRAIN = false;
    bf16_t* O; size_t ldc;
    __device__ __forceinline__ void operator()(const f32x4 (&acc)[2][2][4][2], const Unit& u, int wr, int wc, int fr, int fq) const {
        const int row0 = u.pm * 256 + wr * 64 + fr, col0 = u.pn * 256 + wc * 32 + 8 * fq;
#pragma unroll
        for (int ai = 0; ai < 2; ++ai)
#pragma unroll
            for (int m = 0; m < 4; ++m)
#pragma unroll
                for (int bj = 0; bj < 2; ++bj) { const f32x4 v0 = acc[ai][bj][m][0], v1 = acc[ai][bj][m][1];
                    u32x4 w; w.x = pk2(v0[0], v0[1]); w.y = pk2(v0[2], v0[3]); w.z = pk2(v1[0], v1[1]); w.w = pk2(v1[2], v1[3]);
                    *(u32x4*)(O + (size_t)(row0 + ai * 128 + m * 16) * ldc + col0 + bj * 128) = w; }
    }
};
template <bool GQA> struct EpiQK {
    static constexpr bool PERM = true, AFTER_DRAIN = false;
    bf16_t* O; int ldo; float qscale; const float* qgain; const float* kgain; const float* ropec; const float* ropes;
    __device__ __forceinline__ void operator()(const f32x4 (&acc)[2][2][4][2], const Unit& u, int wr, int wc, int fr, int fq) const {
        const bool isq = u.pn < 4; const float sc = isq ? qscale : 1.0f;
        const int colb = 64 * (4 * u.pn + wc) + 8 * fq;
        f32x4 gn[2][2];
        if (GQA) { const float* gp = isq ? qgain : kgain;
#pragma unroll
            for (int bj = 0; bj < 2; ++bj)
#pragma unroll
                for (int n = 0; n < 2; ++n) gn[bj][n] = *(const f32x4*)(gp + 32 * bj + 16 * n + 4 * fq); }
#pragma unroll
        for (int ai = 0; ai < 2; ++ai)
#pragma unroll
            for (int m = 0; m < 4; ++m) {
                const int row = u.pm * 256 + ai * 128 + wr * 64 + m * 16 + fr;
                f32x4 x[2][2];
#pragma unroll
                for (int bj = 0; bj < 2; ++bj)
#pragma unroll
                    for (int n = 0; n < 2; ++n) x[bj][n] = acc[ai][bj][m][n];
                if (GQA) {
                    float s = 0.f;
#pragma unroll
                    for (int bj = 0; bj < 2; ++bj)
#pragma unroll
                        for (int n = 0; n < 2; ++n) s += (x[bj][n][0] * x[bj][n][0] + x[bj][n][1] * x[bj][n][1]) + (x[bj][n][2] * x[bj][n][2] + x[bj][n][3] * x[bj][n][3]);
                    s += __shfl_xor(s, 16); s += __shfl_xor(s, 32);
                    const float rstd = rsqrtf(s * (1.0f / 64.0f) + EPS);
#pragma unroll
                    for (int bj = 0; bj < 2; ++bj)
#pragma unroll
                        for (int n = 0; n < 2; ++n) x[bj][n] = x[bj][n] * rstd * gn[bj][n];
                    if (u.pm < 256) {
                        const int sidx = row & 4095; const int pos[2] = {sidx >> 6, sidx & 63};
#pragma unroll
                        for (int bj = 0; bj < 2; ++bj) {
                            const f32x4 c = *(const f32x4*)(ropec + pos[bj] * 16 + 4 * fq), sn = *(const f32x4*)(ropes + pos[bj] * 16 + 4 * fq);
                            const f32x4 x1 = x[bj][0], x2 = x[bj][1];
                            x[bj][0] = x1 * c - x2 * sn; x[bj][1] = x2 * c + x1 * sn;
                        }
                    }
                }
#pragma unroll
                for (int bj = 0; bj < 2; ++bj) { const f32x4 v0 = x[bj][0] * sc, v1 = x[bj][1] * sc;
                    u32x4 w; w.x = pk2(v0[0], v0[1]); w.y = pk2(v0[2], v0[3]); w.z = pk2(v1[0], v1[1]); w.w = pk2(v1[2], v1[3]);
                    *(u32x4*)(O + (size_t)row * ldo + colb + 32 * bj) = w; }
            }
    }
};


__device__ __forceinline__ void meta_gemm_y(const bf16_t* A, const bf16_t* Wt, const int K, bf16_t* Y, float* ssqp, unsigned char* smem, const int tid) {
    const int wave = tid >> 6, lane = tid & 63, fr = lane & 15, fq = lane >> 4;
    float* red = (float*)smem;
    const int kw = K >> 3;
    for (int su = blockIdx.x; su < 256; su += gridDim.x) {
        const int rt = su >> 4, ct = su & 15;
        const bf16_t* ap = A + (size_t)(MREAL + 16 * rt + fr) * K + wave * kw + 8 * fq;
        const bf16_t* bp = Wt + (size_t)(64 * ct + fr) * K + wave * kw + 8 * fq;
        f32x4 acc[4];
#pragma unroll
        for (int c4 = 0; c4 < 4; ++c4) acc[c4] = (f32x4){0.f, 0.f, 0.f, 0.f};
#pragma unroll 4
        for (int k = 0; k < kw; k += 32) {
            const bf16x8 a = *(const bf16x8*)(ap + k);
#pragma unroll
            for (int c4 = 0; c4 < 4; ++c4) acc[c4] = __builtin_amdgcn_mfma_f32_16x16x32_bf16(a, *(const bf16x8*)(bp + (size_t)(16 * c4) * K + k), acc[c4], 0, 0, 0);
        }
#pragma unroll
        for (int c4 = 0; c4 < 4; ++c4)
#pragma unroll
            for (int i = 0; i < 4; ++i) red[(wave * 16 + 4 * fq + i) * 64 + 16 * c4 + fr] = acc[c4][i];
        __syncthreads();
        const int row = 2 * wave + (lane >> 5), cp = lane & 31;
        float s0 = 0.f, s1 = 0.f;
#pragma unroll
        for (int w = 0; w < 8; ++w) { const f32x2_t v = *(const f32x2_t*)(red + (w * 16 + row) * 64 + 2 * cp); s0 += v.x; s1 += v.y; }
        const int grow = MREAL + 16 * rt + row;
        *(unsigned*)(Y + (size_t)grow * DM + 64 * ct + 2 * cp) = pk2(s0, s1);
        float q = s0 * s0 + s1 * s1;
        q += __shfl_xor(q, 1); q += __shfl_xor(q, 2); q += __shfl_xor(q, 4); q += __shfl_xor(q, 8); q += __shfl_xor(q, 16);
        if (cp == 0) ssqp[(size_t)grow * 16 + ct] = q;
        __syncthreads();
    }
}

__device__ __forceinline__ void p0_weights(const Params& P, unsigned char* smem, const int tid) {
    float* tile = (float*)smem;
    unsigned char* W = P.ws + WS_W;
    for (int job = 0; job < 14; ++job) {
        const float* srcA; const float* srcB = nullptr; int ld, N, K, kind, coloff = 0; bf16_t* dst;
        const float* gk = nullptr;
        if (job < 8) { const int lj = job >> 1, dn = job & 1;
            if (!dn) gk = P.in[2] + (size_t)((lj >> 1) * 6 + ((lj & 1) ? 4 : 0)) * DM;
            if (!dn) { kind = 0; srcA = P.in[3] + (size_t)lj * DM * FF; srcB = P.in[4] + (size_t)lj * DM * FF; ld = FF; N = 2 * FF; K = DM; dst = (bf16_t*)(W + lj * W_FFN_BYTES); }
            else     { kind = 1; srcA = P.in[5] + (size_t)lj * FF * DM; ld = DM; N = DM; K = FF; dst = (bf16_t*)(W + lj * W_FFN_BYTES + W_GU_BYTES); } }
        else if (job == 8)  { gk = P.in[2] + (size_t)(0 * 6 + 2) * DM; kind = 2; srcA = P.in[6];  ld = 3072; N = 2048; K = DM; dst = (bf16_t*)(W + W_NA_QK); }
        else if (job == 9)  { gk = P.in[2] + (size_t)(0 * 6 + 2) * DM; kind = 1; srcA = P.in[6];  ld = 3072; N = 1024; K = DM; coloff = 2048; dst = (bf16_t*)(W + W_NA_V); }
        else if (job == 10) { kind = 1; srcA = P.in[7];  ld = 1024; N = 1024; K = DM; dst = (bf16_t*)(W + W_NA_O); }
        else if (job == 11) { gk = P.in[2] + (size_t)(1 * 6 + 2) * DM; kind = 3; srcA = P.in[10]; ld = 1536; N = 1280; K = DM; dst = (bf16_t*)(W + W_GQA_QK); }
        else if (job == 12) { gk = P.in[2] + (size_t)(1 * 6 + 2) * DM; kind = 1; srcA = P.in[10]; ld = 1536; N = 256;  K = DM; coloff = 1280; dst = (bf16_t*)(W + W_GQA_V); }
        else                { kind = 1; srcA = P.in[11]; ld = 1024; N = 1024; K = DM; dst = (bf16_t*)(W + W_GQA_O); }
        const int ntn = N / 64, ntk = K / 64;
        for (int t = blockIdx.x; t < ntn * ntk; t += gridDim.x) {
            const int n0 = (t % ntn) * 64, k0 = (t / ntn) * 64;
            const int nn = 4 * (tid & 15), p = n0 + nn;
            const float* cp;
            if (kind == 0) { const int bj = (p >> 7) & 1, col = (p >> 8) * 128 + (p & 127); cp = (bj ? srcB : srcA) + col; }
            else if (kind == 1) cp = srcA + coloff + p;
            else { const int c32 = p & 31, wcw = (p >> 5) & 3, bj = (p >> 7) & 1, pn = p >> 8;
                const int d = (kind == 2) ? (32 * bj + c32) : (32 * bj + 16 * ((c32 >> 2) & 1) + 4 * (c32 >> 3) + (c32 & 3));
                cp = srcA + 64 * (4 * pn + wcw) + d; }
            const float wsc = (kind == 0) ? ((((n0 + nn) >> 7) & 1) ? -0.6931471805599453f : -LOG2E) : 1.0f;
#pragma unroll
            for (int i = 0; i < 2; ++i) { const int kk = (tid >> 4) + 32 * i; const float sck = wsc * (gk ? gk[k0 + kk] : 1.0f);
                const f32x4 w4 = __builtin_nontemporal_load((const f32x4*)(cp + (size_t)(k0 + kk) * ld));
                tile[kk * 65 + nn] = w4[0] * sck; tile[kk * 65 + nn + 1] = w4[1] * sck; tile[kk * 65 + nn + 2] = w4[2] * sck; tile[kk * 65 + nn + 3] = w4[3] * sck; }
            __syncthreads();
            const int nn2 = tid >> 3, ks = (tid & 7) * 8;
            float v[8];
#pragma unroll
            for (int e = 0; e < 8; ++e) v[e] = tile[(ks + e) * 65 + nn2];
            u32x4 w; w.x = pk2(v[0], v[1]); w.y = pk2(v[2], v[3]); w.z = pk2(v[4], v[5]); w.w = pk2(v[6], v[7]);
            *(u32x4*)(dst + (size_t)(n0 + nn2) * K + k0 + ks) = w;
            __syncthreads();
        }
    }
    for (int i = blockIdx.x * NTHREADS + tid; i < 1024; i += gridDim.x * NTHREADS) {
        const int pos = i >> 4, f = i & 15;
        const float freq = __builtin_amdgcn_exp2f(-(float)f * (13.287712379549449f / 16.0f));
        const float ang = (float)pos * freq;
        const float kq = rintf(ang * 0.15915494309189535f);
        float r = fmaf(-kq, 6.28318548202514648f, ang); r = fmaf(-kq, -1.74845553e-07f, r);
        ((float*)(P.ws + WS_ROPE))[i] = __cosf(r); ((float*)(P.ws + WS_ROPE))[1024 + i] = __sinf(r);
    }
}

typedef unsigned u32x2 __attribute__((ext_vector_type(2)));
struct NrRow { f32x4 h[4]; u32x4 y[2]; float ss, rms; };
__device__ __forceinline__ void nr_load(NrRow& R, const Params& P, int row, bool src_input, bool has_y, const bf16_t* h, const bf16_t* y, const float* ssqp, int lane) {
    if (src_input) {
        const float* hs = row < MREAL ? P.in[0] + (size_t)row * DM : P.in[1] + (size_t)((row - MREAL) & 15) * DM;
#pragma unroll
        for (int q = 0; q < 2; ++q) { R.h[2 * q] = *(const f32x4*)(hs + 8 * lane + 512 * q); R.h[2 * q + 1] = *(const f32x4*)(hs + 8 * lane + 512 * q + 4); }
    } else {
#pragma unroll
        for (int q = 0; q < 2; ++q) { const u32x4 w = __builtin_nontemporal_load((const u32x4*)(h + (size_t)row * DM + 8 * lane + 512 * q));
            R.h[2 * q] = (f32x4){bf_lo(w.x), bf_hi(w.x), bf_lo(w.y), bf_hi(w.y)}; R.h[2 * q + 1] = (f32x4){bf_lo(w.z), bf_hi(w.z), bf_lo(w.w), bf_hi(w.w)}; }
        R.rms = ((const float*)(P.ws + WS_RMS))[row];
    }
    if (has_y) {
#pragma unroll
        for (int q = 0; q < 2; ++q) R.y[q] = __builtin_nontemporal_load((const u32x4*)(y + (size_t)row * DM + 8 * lane + 512 * q));
        R.ss = ssqp[(size_t)row * 16 + (lane & 15)];
    }
}
__device__ __forceinline__ void nr_phase(const Params& P, bool src_input, bool has_y, bool write_h, bool final_out, float coef, const float* gpost, const float* gpre, const int tid) {
    const int wave = tid >> 6, lane = tid & 63;
    bf16_t* xn = (bf16_t*)(P.ws + WS_XN); bf16_t* h = xn; const bf16_t* y = (const bf16_t*)(P.ws + WS_Y); const float* ssqp = (const float*)(P.ws + WS_SSQ); float* rmsb = (float*)(P.ws + WS_RMS);
    f32x4 gp[4];
#pragma unroll
    for (int q = 0; q < 2; ++q) { gp[2 * q] = *(const f32x4*)(gpost + 8 * lane + 512 * q); gp[2 * q + 1] = *(const f32x4*)(gpost + 8 * lane + 512 * q + 4); }
    const int stride = gridDim.x * 8;
    int row = blockIdx.x * 8 + wave;
    NrRow nx, nx2;
    if (row < MTOK) nr_load(nx, P, row, src_input, has_y, h, y, ssqp, lane);
    if (row + stride < MTOK) nr_load(nx2, P, row + stride, src_input, has_y, h, y, ssqp, lane);
    for (; row < MTOK; row += stride) {
        NrRow cu = nx; nx = nx2;
        if (row + 2 * stride < MTOK) nr_load(nx2, P, row + 2 * stride, src_input, has_y, h, y, ssqp, lane);
        f32x4 v[4];
#pragma unroll
        for (int j = 0; j < 4; ++j) v[j] = src_input ? cu.h[j] : cu.h[j] * cu.rms;
        if (has_y) {
            float ss = cu.ss; ss += __shfl_xor(ss, 1); ss += __shfl_xor(ss, 2); ss += __shfl_xor(ss, 4); ss += __shfl_xor(ss, 8);
            const float sc = coef * rsqrtf(ss * (1.0f / DM) + EPS);
#pragma unroll
            for (int q = 0; q < 2; ++q) { const u32x4 w = cu.y[q];
                v[2 * q] += (f32x4){bf_lo(w.x), bf_hi(w.x), bf_lo(w.y), bf_hi(w.y)} * gp[2 * q] * sc;
                v[2 * q + 1] += (f32x4){bf_lo(w.z), bf_hi(w.z), bf_lo(w.w), bf_hi(w.w)} * gp[2 * q + 1] * sc; }
        }
        if (final_out) {
            if (row < MREAL) { float* o = P.out + (size_t)row * DM;
#pragma unroll
                for (int q = 0; q < 2; ++q) { *(f32x4*)(o + 8 * lane + 512 * q) = v[2 * q]; *(f32x4*)(o + 8 * lane + 512 * q + 4) = v[2 * q + 1]; } }
            continue;
        }
        float s2 = 0.f;
#pragma unroll
        for (int j = 0; j < 4; ++j) s2 += (v[j][0] * v[j][0] + v[j][1] * v[j][1]) + (v[j][2] * v[j][2] + v[j][3] * v[j][3]);
        s2 = wave_sum(s2);
        const float ms = s2 * (1.0f / DM) + EPS, r2 = rsqrtf(ms);
        if (lane == 0) rmsb[row] = ms * r2;
#pragma unroll
        for (int q = 0; q < 2; ++q) { const f32x4 a = v[2 * q] * r2, b = v[2 * q + 1] * r2; u32x4 w; w.x = pk2(a[0], a[1]); w.y = pk2(a[2], a[3]); w.z = pk2(b[0], b[1]); w.w = pk2(b[2], b[3]);
            *(u32x4*)(xn + (size_t)row * DM + 8 * lane + 512 * q) = w; }
    }
}

struct NaiveState { float m, l; float o[64]; };
__device__ __forceinline__ void naive_key(NaiveState& st, const float (&q)[64], const bf16_t* krow, const bf16_t* vcol  , float bias2) {
    float s = bias2;
#pragma unroll
    for (int c = 0; c < 8; ++c) { const u32x4 kw = *(const u32x4*)(krow + 8 * c);
        s += q[8 * c + 0] * bf_lo(kw.x) + q[8 * c + 1] * bf_hi(kw.x) + q[8 * c + 2] * bf_lo(kw.y) + q[8 * c + 3] * bf_hi(kw.y)
           + q[8 * c + 4] * bf_lo(kw.z) + q[8 * c + 5] * bf_hi(kw.z) + q[8 * c + 6] * bf_lo(kw.w) + q[8 * c + 7] * bf_hi(kw.w); }
    const float mn = fmaxf(st.m, s), corr = __builtin_amdgcn_exp2f(st.m - mn), p = __builtin_amdgcn_exp2f(s - mn);
    st.m = mn; st.l = st.l * corr + p;
#pragma unroll
    for (int d = 0; d < 64; ++d) st.o[d] = st.o[d] * corr + p * __uint_as_float((unsigned)vcol[(size_t)d * MTOK] << 16);
}
__device__ __forceinline__ void naive_load_q(float (&q)[64], const bf16_t* qp) {
#pragma unroll
    for (int c = 0; c < 8; ++c) { const u32x4 w = *(const u32x4*)(qp + 8 * c);
        q[8 * c + 0] = bf_lo(w.x); q[8 * c + 1] = bf_hi(w.x); q[8 * c + 2] = bf_lo(w.y); q[8 * c + 3] = bf_hi(w.y);
        q[8 * c + 4] = bf_lo(w.z); q[8 * c + 5] = bf_hi(w.z); q[8 * c + 6] = bf_lo(w.w); q[8 * c + 7] = bf_hi(w.w); }
}
__device__ __forceinline__ void naive_store_o(const NaiveState& st, bf16_t* op) {
    const float inv = 1.0f / st.l;
#pragma unroll
    for (int c = 0; c < 8; ++c) { u32x4 w; w.x = pk2(st.o[8 * c] * inv, st.o[8 * c + 1] * inv); w.y = pk2(st.o[8 * c + 2] * inv, st.o[8 * c + 3] * inv);
        w.z = pk2(st.o[8 * c + 4] * inv, st.o[8 * c + 5] * inv); w.w = pk2(st.o[8 * c + 6] * inv, st.o[8 * c + 7] * inv); *(u32x4*)(op + 8 * c) = w; }
}
__device__ __forceinline__ void na_attn_naive(const Params& P, const int tid) {
    const bf16_t* qk = (const bf16_t*)(P.ws + WS_BIG); const bf16_t* vt = (const bf16_t*)(P.ws + WS_VT); bf16_t* o = (bf16_t*)(P.ws + WS_H);
    const float* rpb = P.in[8]; const float* mbias = P.in[9];
    const int wave = tid >> 6, lane = tid & 63;
    for (int u = blockIdx.x * 8 + wave; u < 16384 + 256; u += gridDim.x * 8) {
        const bool meta = u >= 16384;
        int b, hd, r;
        if (!meta) { hd = u & 15; r = (u >> 4) & 63; b = u >> 10; } else { const int t = u - 16384; hd = t & 15; b = t >> 4; r = 0; }
        if (meta && lane >= 16) continue;
        const int c = lane;
        const int qrow = meta ? MREAL + b * 16 + lane : b * 4096 + r * 64 + c;
        float q[64]; naive_load_q(q, qk + (size_t)qrow * 2048 + hd * 64);
        NaiveState st; st.m = -1e30f; st.l = 0.f;
#pragma unroll
        for (int d = 0; d < 64; ++d) st.o[d] = 0.f;
        const bf16_t* vh = vt + (size_t)(hd * 64) * MTOK;
        for (int j = 0; j < 16; ++j) { const int krow = MREAL + b * 16 + j;
            naive_key(st, q, qk + (size_t)krow * 2048 + 1024 + hd * 64, vh + krow, meta ? 0.f : mbias[hd * 16 + j] * LOG2E); }
        if (!meta) {
            const int rs = min(max(r - 4, 0), 56), cs = min(max(c - 8, 0), 48);
            for (int i = 0; i < 8; ++i)
                for (int j = 0; j < 16; ++j) { const int krow = b * 4096 + (rs + i) * 64 + cs + j;
                    const float bias = rpb[(hd * 15 + (rs + i - r + 7)) * 31 + (cs + j - c + 15)];
                    naive_key(st, q, qk + (size_t)krow * 2048 + 1024 + hd * 64, vh + krow, bias * LOG2E); }
        }
        naive_store_o(st, o + (size_t)qrow * DM + hd * 64);
    }
}
__device__ __forceinline__ void gqa_attn_naive(const Params& P, const int tid) {
    const bf16_t* qk = (const bf16_t*)(P.ws + WS_BIG); const bf16_t* vt = (const bf16_t*)(P.ws + WS_VT); bf16_t* o = (bf16_t*)(P.ws + WS_H);
    const int wave = tid >> 6, lane = tid & 63;
    for (int u = blockIdx.x * 8 + wave; u < 16384 + 256; u += gridDim.x * 8) {
        const bool meta = u >= 16384;
        int b, hd, qb;
        if (!meta) { qb = u & 63; hd = (u >> 6) & 15; b = u >> 10; } else { const int t = u - 16384; hd = t & 15; b = t >> 4; qb = 0; }
        if (meta && lane >= 16) continue;
        const int kvh = hd >> 2;
        const int qrow = meta ? MREAL + b * 16 + lane : b * 4096 + qb * 64 + lane;
        float q[64]; naive_load_q(q, qk + (size_t)qrow * 1280 + hd * 64);
        NaiveState st; st.m = -1e30f; st.l = 0.f;
#pragma unroll
        for (int d = 0; d < 64; ++d) st.o[d] = 0.f;
        const bf16_t* vh = vt + (size_t)(kvh * 64) * MTOK;
        for (int j = 0; j < 4096 + 16; ++j) { const int krow = j < 4096 ? b * 4096 + j : MREAL + b * 16 + (j - 4096);
            naive_key(st, q, qk + (size_t)krow * 1280 + 1024 + kvh * 64, vh + krow, 0.f); }
        naive_store_o(st, o + (size_t)qrow * DM + hd * 64);
    }
}


typedef float f32x16 __attribute__((ext_vector_type(16)));
constexpr int ATT_ROWB = 144, ATT_KB = 64 * ATT_ROWB, ATT_BUF = 2 * ATT_KB;
template <bool FIXEDM> __device__ __forceinline__ void gqa_attn_fast(const Params& P, unsigned char* smem, const int tid, const float bnd) {
    const bf16_t* qk = (const bf16_t*)(P.ws + WS_BIG); const bf16_t* vt = (const bf16_t*)(P.ws + WS_VT); bf16_t* o = (bf16_t*)(P.ws + WS_H);
    const int wave = tid >> 6, lane = tid & 63, r = lane & 31, h = lane >> 5, qsub = wave & 3, hp = wave >> 2;
    const int G = gridDim.x, bx = blockIdx.x;
    const int skey = tid >> 3, sch = tid & 7;
    const int kapr = (r & ~12) | ((r & 4) << 1) | ((r & 8) >> 1);
    const u32x4 zero4 = {0u, 0u, 0u, 0u};
    for (int it = 0;; ++it) {
        const int ulin = it * G + bx;
        if (ulin >= 2048 + 64) break;
        const bool meta = ulin >= 2048;
        int bk, qb;
        if (meta) { bk = ulin - 2048; qb = 0; }
        else if (G == 256) { bk = it * 8 + (bx & 7); qb = bx >> 3; }
        else { bk = ulin >> 5; qb = ulin & 31; }
        const int b = bk >> 2, kvh = bk & 3;
        const int ftile = meta ? qsub : 0;
        const int qrow = meta ? MREAL + b * 16 + (r & 15) : b * 4096 + qb * 128 + qsub * 32 + r;
        bf16x8 qf[2][4];
#pragma unroll
        for (int t = 0; t < 2; ++t)
#pragma unroll
            for (int s = 0; s < 4; ++s) qf[t][s] = *(const bf16x8*)(qk + (size_t)qrow * 1280 + (kvh * 4 + hp * 2 + t) * 64 + 16 * s + 8 * h);
        f32x16 O[2][2], negm[2], L; float l[2];
        const unsigned on0 = (r < 16) ? 0x3f803f80u : 0u, on1 = (r < 16) ? 0u : 0x3f803f80u;
        const u32x4 a0_u = {on0, on0, on0, on0}, a1_u = {on1, on1, on1, on1}; const bf16x8 onesA[2] = {__builtin_bit_cast(bf16x8, a0_u), __builtin_bit_cast(bf16x8, a1_u)};
#pragma unroll
        for (int t = 0; t < 2; ++t) { l[t] = 0.f;
#pragma unroll
            for (int i = 0; i < 16; ++i) { negm[t][i] = FIXEDM ? -bnd : 0.f; L[i] = 0.f; }
#pragma unroll
            for (int dt = 0; dt < 2; ++dt)
#pragma unroll
                for (int i = 0; i < 16; ++i) O[t][dt][i] = 0.f; }
        const bf16_t* kbase = qk + 1024 + kvh * 64 + sch * 8;
        const bf16_t* vbase = vt + (size_t)(kvh * 64 + skey) * MTOK + sch * 8;
        u32x4 kr, vr;
        { const int krow0 = b * 4096;
          kr = *(const u32x4*)(kbase + (size_t)(krow0 + skey) * 1280); vr = *(const u32x4*)(vbase + krow0);
          *(u32x4*)(smem + skey * ATT_ROWB + sch * 16) = kr; *(u32x4*)(smem + ATT_KB + skey * ATT_ROWB + sch * 16) = vr; }
        __syncthreads();
        for (int tile = 0; tile <= 64; ++tile) {
            const int buf = tile & 1;
            if (tile < 64) {
                const int nt = tile + 1;
                if (nt < 64) { const int krow0 = b * 4096 + nt * 64; kr = *(const u32x4*)(kbase + (size_t)(krow0 + skey) * 1280); vr = *(const u32x4*)(vbase + krow0); }
                else { const int krow0 = MREAL + b * 16;
                    kr = skey < 16 ? *(const u32x4*)(kbase + (size_t)(krow0 + skey) * 1280) : zero4;
                    vr = sch < 2 ? *(const u32x4*)(vbase + krow0) : zero4; }
            }
            if (!meta || (tile & 3) == qsub) {
                const unsigned char* Kb = smem + buf * ATT_BUF; const unsigned char* Vb = Kb + ATT_KB;
                if (FIXEDM && tile < 64) {
#pragma unroll
                for (int sub = 0; sub < 2; ++sub) {
                    bf16x8 kf[4], vf[2][2];
#pragma unroll
                    for (int s = 0; s < 4; ++s) kf[s] = *(const bf16x8*)(Kb + (sub * 32 + kapr) * ATT_ROWB + (16 * s + 8 * h) * 2);
#pragma unroll
                    for (int dt = 0; dt < 2; ++dt)
#pragma unroll
                        for (int s2 = 0; s2 < 2; ++s2) vf[dt][s2] = *(const bf16x8*)(Vb + (dt * 32 + r) * ATT_ROWB + (sub * 32 + 16 * s2 + 8 * h) * 2);
#pragma unroll
                    for (int t = 0; t < 2; ++t) {
                        f32x16 S = __builtin_amdgcn_mfma_f32_32x32x16_bf16(kf[0], qf[t][0], negm[FIXEDM ? 0 : t], 0, 0, 0);
#pragma unroll
                        for (int s = 1; s < 4; ++s) S = __builtin_amdgcn_mfma_f32_32x32x16_bf16(kf[s], qf[t][s], S, 0, 0, 0);
                        if (tile == 64) {
#pragma unroll
                            for (int i = 8; i < 16; ++i) S[i] = -1e30f;
                        }
                        if (!FIXEDM) {
                        float mx = fmaxf(fmaxf(S[0], S[1]), S[2]);
#pragma unroll
                        for (int i = 3; i < 15; i += 2) mx = fmaxf(fmaxf(mx, S[i]), S[i + 1]);
                        mx = fmaxf(mx, S[15]);
                        mx = fmaxf(mx, __shfl_xor(mx, 32));
                        const bool first = (tile == ftile) && (sub == 0);
                        if (first || __ballot(mx > 8.0f) != 0ull) {
                            const float d = first ? mx : fmaxf(mx, 0.f), alpha = first ? 1.0f : __builtin_amdgcn_exp2f(-d);
#pragma unroll
                            for (int i = 0; i < 16; ++i) { S[i] -= d; negm[t][i] -= d; }
#pragma unroll
                            for (int i = 0; i < 8; ++i) L[8 * t + i] *= alpha;
#pragma unroll
                            for (int dt = 0; dt < 2; ++dt)
#pragma unroll
                                for (int i = 0; i < 16; ++i) O[t][dt][i] *= alpha;
                        }
                        }
#pragma unroll
                        for (int i = 0; i < 16; ++i) S[i] = __builtin_amdgcn_exp2f(S[i]);
                        bf16x8 pf[2];
#pragma unroll
                        for (int s2 = 0; s2 < 2; ++s2) { u32x4 w; w.x = pk2(S[8 * s2], S[8 * s2 + 1]); w.y = pk2(S[8 * s2 + 2], S[8 * s2 + 3]);
                            w.z = pk2(S[8 * s2 + 4], S[8 * s2 + 5]); w.w = pk2(S[8 * s2 + 6], S[8 * s2 + 7]); pf[s2] = __builtin_bit_cast(bf16x8, w); }
#pragma unroll
                        for (int dt = 0; dt < 2; ++dt)
#pragma unroll
                            for (int s2 = 0; s2 < 2; ++s2) O[t][dt] = __builtin_amdgcn_mfma_f32_32x32x16_bf16(vf[dt][s2], pf[s2], O[t][dt], 0, 0, 0);
                        L = __builtin_amdgcn_mfma_f32_32x32x16_bf16(onesA[t], pf[0], L, 0, 0, 0);
                        L = __builtin_amdgcn_mfma_f32_32x32x16_bf16(onesA[t], pf[1], L, 0, 0, 0);
                    }
                }
                } else {
                const int nsub = tile < 64 ? 2 : 1;
#pragma unroll 1
                for (int sub = 0; sub < nsub; ++sub) {
                    bf16x8 kf[4], vf[2][2];
#pragma unroll
                    for (int s = 0; s < 4; ++s) kf[s] = *(const bf16x8*)(Kb + (sub * 32 + kapr) * ATT_ROWB + (16 * s + 8 * h) * 2);
#pragma unroll
                    for (int dt = 0; dt < 2; ++dt)
#pragma unroll
                        for (int s2 = 0; s2 < 2; ++s2) vf[dt][s2] = *(const bf16x8*)(Vb + (dt * 32 + r) * ATT_ROWB + (sub * 32 + 16 * s2 + 8 * h) * 2);
#pragma unroll
                    for (int t = 0; t < 2; ++t) {
                        f32x16 S = __builtin_amdgcn_mfma_f32_32x32x16_bf16(kf[0], qf[t][0], negm[FIXEDM ? 0 : t], 0, 0, 0);
#pragma unroll
                        for (int s = 1; s < 4; ++s) S = __builtin_amdgcn_mfma_f32_32x32x16_bf16(kf[s], qf[t][s], S, 0, 0, 0);
                        if (tile == 64) {
#pragma unroll
                            for (int i = 8; i < 16; ++i) S[i] = -1e30f;
                        }
                        if (!FIXEDM) {
                        float mx = fmaxf(fmaxf(S[0], S[1]), S[2]);
#pragma unroll
                        for (int i = 3; i < 15; i += 2) mx = fmaxf(fmaxf(mx, S[i]), S[i + 1]);
                        mx = fmaxf(mx, S[15]);
                        mx = fmaxf(mx, __shfl_xor(mx, 32));
                        const bool first = (tile == ftile) && (sub == 0);
                        if (first || __ballot(mx > 8.0f) != 0ull) {
                            const float d = first ? mx : fmaxf(mx, 0.f), alpha = first ? 1.0f : __builtin_amdgcn_exp2f(-d);
#pragma unroll
                            for (int i = 0; i < 16; ++i) { S[i] -= d; negm[t][i] -= d; }
#pragma unroll
                            for (int i = 0; i < 8; ++i) L[8 * t + i] *= alpha;
#pragma unroll
                            for (int dt = 0; dt < 2; ++dt)
#pragma unroll
                                for (int i = 0; i < 16; ++i) O[t][dt][i] *= alpha;
                        }
                        }
#pragma unroll
                        for (int i = 0; i < 16; ++i) S[i] = __builtin_amdgcn_exp2f(S[i]);
                        bf16x8 pf[2];
#pragma unroll
                        for (int s2 = 0; s2 < 2; ++s2) { u32x4 w; w.x = pk2(S[8 * s2], S[8 * s2 + 1]); w.y = pk2(S[8 * s2 + 2], S[8 * s2 + 3]);
                            w.z = pk2(S[8 * s2 + 4], S[8 * s2 + 5]); w.w = pk2(S[8 * s2 + 6], S[8 * s2 + 7]); pf[s2] = __builtin_bit_cast(bf16x8, w); }
#pragma unroll
                        for (int dt = 0; dt < 2; ++dt)
#pragma unroll
                            for (int s2 = 0; s2 < 2; ++s2) O[t][dt] = __builtin_amdgcn_mfma_f32_32x32x16_bf16(vf[dt][s2], pf[s2], O[t][dt], 0, 0, 0);
                        L = __builtin_amdgcn_mfma_f32_32x32x16_bf16(onesA[t], pf[0], L, 0, 0, 0);
                        L = __builtin_amdgcn_mfma_f32_32x32x16_bf16(onesA[t], pf[1], L, 0, 0, 0);
                    }
                }
                }
}
            if (tile < 64) { const int nb = buf ^ 1;
                *(u32x4*)(smem + nb * ATT_BUF + skey * ATT_ROWB + sch * 16) = kr; *(u32x4*)(smem + nb * ATT_BUF + ATT_KB + skey * ATT_ROWB + sch * 16) = vr; }
            __syncthreads();
        }
        l[0] = L[0]; l[1] = L[8];
        if (meta) {
            if (qsub != 0) {
#pragma unroll
                for (int t = 0; t < 2; ++t) { unsigned poff = (unsigned)((((hp * 3 + qsub - 1) * 2 + t) * 34) * 64 + lane) * 4u; asm volatile("" : "+v"(poff));
                    float* p = (float*)(smem + poff);
                    p[0] = negm[t][0]; p[64] = l[t];
#pragma unroll
                    for (int dt = 0; dt < 2; ++dt)
#pragma unroll
                        for (int i = 0; i < 16; ++i) p[(2 + dt * 16 + i) * 64] = O[t][dt][i]; }
            }
            __syncthreads();
            if (qsub == 0) {
#pragma unroll
                for (int t = 0; t < 2; ++t) {
                    unsigned p0off = (unsigned)(((hp * 3 * 2 + t) * 34) * 64 + lane) * 4u; asm volatile("" : "+v"(p0off));
                    const float* p0 = (const float*)(smem + p0off);
                    const float n0 = negm[t][0], n1 = p0[0], n2 = p0[(size_t)2 * 34 * 64], n3 = p0[(size_t)4 * 34 * 64];
                    const float ns = fminf(fminf(n0, n1), fminf(n2, n3));
                    const float f0 = __builtin_amdgcn_exp2f(ns - n0);
                    l[t] *= f0;
#pragma unroll
                    for (int dt = 0; dt < 2; ++dt)
#pragma unroll
                        for (int i = 0; i < 16; ++i) O[t][dt][i] *= f0;
#pragma unroll 1
                    for (int w = 0; w < 3; ++w) { const float* p = p0 + (size_t)(w * 2 * 34) * 64; const float fw = __builtin_amdgcn_exp2f(ns - p[0]);
                        l[t] += fw * p[64];
#pragma unroll
                        for (int dt = 0; dt < 2; ++dt)
#pragma unroll
                            for (int i = 0; i < 16; ++i) O[t][dt][i] += fw * p[(2 + dt * 16 + i) * 64]; }
                }
            }
            __syncthreads();
        }
        if (!meta || (qsub == 0 && r < 16)) {
#pragma unroll
            for (int t = 0; t < 2; ++t) {
                const float lt = l[t]; const float inv = 1.0f / lt;
                bf16_t* op = o + (size_t)qrow * DM + (kvh * 4 + hp * 2 + t) * 64 + 4 * h;
#pragma unroll
                for (int dt = 0; dt < 2; ++dt)
#pragma unroll
                    for (int g = 0; g < 4; ++g) { unsigned w0 = pk2(O[t][dt][4 * g] * inv, O[t][dt][4 * g + 1] * inv), w1 = pk2(O[t][dt][4 * g + 2] * inv, O[t][dt][4 * g + 3] * inv);
                        unsigned long long w = (unsigned long long)w0 | ((unsigned long long)w1 << 32);
                        *(unsigned long long*)(op + 32 * dt + 8 * g) = w; }
            }
        }
    }
}


__device__ __forceinline__ void osm_update(f32x16& S, float& m, float& l, f32x16 (&O)[2]) {
    float mx = S[0];
#pragma unroll
    for (int i = 1; i < 16; ++i) mx = fmaxf(mx, S[i]);
    mx = fmaxf(mx, __shfl_xor(mx, 32));
    const float mn = fmaxf(m, mx), alpha = __builtin_amdgcn_exp2f(m - mn);
    m = mn;
    float rs = 0.f;
#pragma unroll
    for (int i = 0; i < 16; ++i) { S[i] = __builtin_amdgcn_exp2f(S[i] - mn); rs += S[i]; }
    l = l * alpha + rs;
#pragma unroll
    for (int dt = 0; dt < 2; ++dt)
#pragma unroll
        for (int i = 0; i < 16; ++i) O[dt][i] *= alpha;
}
__device__ __forceinline__ bf16x8 pack_p(const f32x16& S, int s2) {
    u32x4 w; w.x = pk2(S[8 * s2], S[8 * s2 + 1]); w.y = pk2(S[8 * s2 + 2], S[8 * s2 + 3]); w.z = pk2(S[8 * s2 + 4], S[8 * s2 + 5]); w.w = pk2(S[8 * s2 + 6], S[8 * s2 + 7]);
    return __builtin_bit_cast(bf16x8, w);
}
__device__ __forceinline__ void osm_lazy(f32x16& S, f32x16& negm, float& l, f32x16 (&O)[2], const bool first) {
    float mx = fmaxf(fmaxf(S[0], S[1]), S[2]);
#pragma unroll
    for (int i = 3; i < 15; i += 2) mx = fmaxf(fmaxf(mx, S[i]), S[i + 1]);
    mx = fmaxf(mx, S[15]);
    mx = fmaxf(mx, __shfl_xor(mx, 32));
    if (first || __ballot(mx > 8.0f) != 0ull) {
        const float d = first ? mx : fmaxf(mx, 0.f), alpha = first ? 1.0f : __builtin_amdgcn_exp2f(-d);
        l *= alpha;
#pragma unroll
        for (int i = 0; i < 16; ++i) { S[i] -= d; negm[i] -= d; }
#pragma unroll
        for (int dt = 0; dt < 2; ++dt)
#pragma unroll
            for (int i = 0; i < 16; ++i) O[dt][i] *= alpha;
    }
    f32x2_t rs2 = {0.f, 0.f};
#pragma unroll
    for (int i = 0; i < 16; i += 2) { S[i] = __builtin_amdgcn_exp2f(S[i]); S[i + 1] = __builtin_amdgcn_exp2f(S[i + 1]); rs2 += (f32x2_t){S[i], S[i + 1]}; }
    l += rs2.x + rs2.y;
}
__device__ __forceinline__ void osm_lazy_pair(f32x16& S0, f32x16& S1, f32x16& negm, float& l, f32x16 (&O)[2]) {
    float mx = fmaxf(fmaxf(S0[0], S0[1]), S0[2]), my = fmaxf(fmaxf(S1[0], S1[1]), S1[2]);
#pragma unroll
    for (int i = 3; i < 15; i += 2) { mx = fmaxf(fmaxf(mx, S0[i]), S0[i + 1]); my = fmaxf(fmaxf(my, S1[i]), S1[i + 1]); }
    mx = fmaxf(fmaxf(mx, S0[15]), fmaxf(my, S1[15]));
    mx = fmaxf(mx, __shfl_xor(mx, 32));
    if (__ballot(mx > 8.0f) != 0ull) {
        const float d = fmaxf(mx, 0.f), alpha = __builtin_amdgcn_exp2f(-d);
        l *= alpha;
#pragma unroll
        for (int i = 0; i < 16; ++i) { S0[i] -= d; S1[i] -= d; negm[i] -= d; }
#pragma unroll
        for (int dt = 0; dt < 2; ++dt)
#pragma unroll
            for (int i = 0; i < 16; ++i) O[dt][i] *= alpha;
    }
    float ra = 0.f, rb = 0.f, rc = 0.f, rd = 0.f;
#pragma unroll
    for (int i = 0; i < 16; i += 2) { S0[i] = __builtin_amdgcn_exp2f(S0[i]); S1[i] = __builtin_amdgcn_exp2f(S1[i]); S0[i + 1] = __builtin_amdgcn_exp2f(S0[i + 1]); S1[i + 1] = __builtin_amdgcn_exp2f(S1[i + 1]);
        ra += S0[i]; rb += S1[i]; rc += S0[i + 1]; rd += S1[i + 1]; }
    l += (ra + rb) + (rc + rd);
}
__device__ __forceinline__ void osm_lazy_pair2(f32x16& S0, f32x16& S1, f32x16& Ca, f32x16& Cb, float& l, f32x16 (&O)[2]) {
    float mx = fmaxf(fmaxf(S0[0], S0[1]), S0[2]), my = fmaxf(fmaxf(S1[0], S1[1]), S1[2]);
#pragma unroll
    for (int i = 3; i < 15; i += 2) { mx = fmaxf(fmaxf(mx, S0[i]), S0[i + 1]); my = fmaxf(fmaxf(my, S1[i]), S1[i + 1]); }
    mx = fmaxf(fmaxf(mx, S0[15]), fmaxf(my, S1[15]));
    mx = fmaxf(mx, __shfl_xor(mx, 32));
    if (__ballot(mx > 8.0f) != 0ull) {
        const float d = fmaxf(mx, 0.f), alpha = __builtin_amdgcn_exp2f(-d);
        l *= alpha;
#pragma unroll
        for (int i = 0; i < 16; ++i) { S0[i] -= d; S1[i] -= d; Ca[i] -= d; Cb[i] -= d; }
#pragma unroll
        for (int dt = 0; dt < 2; ++dt)
#pragma unroll
            for (int i = 0; i < 16; ++i) O[dt][i] *= alpha;
    }
    float ra = 0.f, rb = 0.f, rc = 0.f, rd = 0.f;
#pragma unroll
    for (int i = 0; i < 16; i += 2) { S0[i] = __builtin_amdgcn_exp2f(S0[i]); S1[i] = __builtin_amdgcn_exp2f(S1[i]); S0[i + 1] = __builtin_amdgcn_exp2f(S0[i + 1]); S1[i + 1] = __builtin_amdgcn_exp2f(S1[i + 1]);
        ra += S0[i]; rb += S1[i]; rc += S0[i + 1]; rd += S1[i + 1]; }
    l += (ra + rb) + (rc + rd);
}
__device__ __forceinline__ void osm_lazy2(f32x16& S, f32x16& Ca, f32x16& Cb, float& l, f32x16 (&O)[2], const bool first) {
    float mx = fmaxf(fmaxf(S[0], S[1]), S[2]);
#pragma unroll
    for (int i = 3; i < 15; i += 2) mx = fmaxf(fmaxf(mx, S[i]), S[i + 1]);
    mx = fmaxf(mx, S[15]);
    mx = fmaxf(mx, __shfl_xor(mx, 32));
    if (first || __ballot(mx > 8.0f) != 0ull) {
        const float d = first ? mx : fmaxf(mx, 0.f), alpha = first ? 1.0f : __builtin_amdgcn_exp2f(-d);
        l *= alpha;
#pragma unroll
        for (int i = 0; i < 16; ++i) { S[i] -= d; Ca[i] -= d; Cb[i] -= d; }
#pragma unroll
        for (int dt = 0; dt < 2; ++dt)
#pragma unroll
            for (int i = 0; i < 16; ++i) O[dt][i] *= alpha;
    }
    float ra = 0.f, rb = 0.f;
#pragma unroll
    for (int i = 0; i < 16; i += 2) { S[i] = __builtin_amdgcn_exp2f(S[i]); S[i + 1] = __builtin_amdgcn_exp2f(S[i + 1]); ra += S[i]; rb += S[i + 1]; }
    l += ra + rb;
}
constexpr int NA_TBL_OFF = 2 * ATT_BUF + 4096;
__device__ __forceinline__ void na_attn_fast(const Params& P, unsigned char* smem, const int tid) {
    const bf16_t* qk = (const bf16_t*)(P.ws + WS_BIG); const bf16_t* vt = (const bf16_t*)(P.ws + WS_VT); bf16_t* o = (bf16_t*)(P.ws + WS_H);
    const float* rpb = P.in[8]; const float* mbias = P.in[9];
    const int wave = tid >> 6, lane = tid & 63, r = lane & 31, h = lane >> 5;
    const int G = gridDim.x, bx = blockIdx.x;
    const int vb = (G % 8 == 0) ? (bx % 8) * (G / 8) + bx / 8 : bx;
    const int kapr = (r & ~12) | ((r & 4) << 1) | ((r & 8) >> 1);
    const int skey = tid >> 3, sch = tid & 7;
    float* tbl = (float*)(smem + NA_TBL_OFF);
    for (int i = tid; i < 16 * 465; i += NTHREADS) tbl[i] = rpb[i] * LOG2E;
    if (tid < 64) tbl[-64 + tid] = 0.f;
    else if (tid < 192) tbl[16 * 465 + (tid - 64)] = 0.f;
    __syncthreads();
    const int rr = wave >> 1, half = wave & 1, c = 32 * half + r, cs = min(max(c - 8, 0), 48), w0 = 8 * h - cs;
    f32x16 madd[2];
#pragma unroll
    for (int tl = 0; tl < 2; ++tl)
#pragma unroll
        for (int i = 0; i < 16; ++i) madd[tl][i] = ((unsigned)(32 * tl + 16 * (i >> 3) + (i & 7) + w0) < 16u) ? 0.f : -1e30f;
    for (int U = vb; U < 4096; U += G) {
        const int rgp = U & 15, hd = (U >> 4) & 15, b = U >> 8;
        const int R0 = 4 * rgp, rg = R0 + rr, rs = min(max(rg - 4, 0), 56);
        const int jlo = min(max(R0 - 4, 0), 56), nrows = min(max(R0 - 1, 0), 56) + 8 - jlo;
        const int qrow = b * 4096 + rg * 64 + c;
        bf16x8 qf[4];
#pragma unroll
        for (int s = 0; s < 4; ++s) qf[s] = *(const bf16x8*)(qk + (size_t)qrow * 2048 + hd * 64 + 16 * s + 8 * h);
        f32x16 O[2], cm[2], zero16; float l = 0.f;
#pragma unroll
        for (int i = 0; i < 16; ++i) { zero16[i] = 0.f; cm[0][i] = madd[0][i]; cm[1][i] = madd[1][i]; }
#pragma unroll
        for (int dt = 0; dt < 2; ++dt)
#pragma unroll
            for (int i = 0; i < 16; ++i) O[dt][i] = 0.f;
        const bf16_t* kbase = qk + 1024 + hd * 64 + sch * 8;
        const bf16_t* vbase = vt + (size_t)(hd * 64 + skey) * MTOK + sch * 8;
        u32x4 kr, vr;
        { const int krow0 = b * 4096 + jlo * 64;
          kr = *(const u32x4*)(kbase + (size_t)(krow0 + skey) * 2048); vr = *(const u32x4*)(vbase + krow0); }
        {
            const bf16_t* kp = qk + (size_t)(MREAL + b * 16 + (kapr & 15)) * 2048 + 1024 + hd * 64 + 8 * h;
            const bf16_t* vh = vt + (size_t)(hd * 64 + r) * MTOK + (MREAL + b * 16 + 8 * h);
            f32x16 S = __builtin_amdgcn_mfma_f32_32x32x16_bf16(*(const bf16x8*)(kp), qf[0], zero16, 0, 0, 0);
#pragma unroll
            for (int s = 1; s < 4; ++s) S = __builtin_amdgcn_mfma_f32_32x32x16_bf16(*(const bf16x8*)(kp + 16 * s), qf[s], S, 0, 0, 0);
            const f32x4 b0 = *(const f32x4*)(mbias + hd * 16 + 8 * h), b1 = *(const f32x4*)(mbias + hd * 16 + 8 * h + 4);
#pragma unroll
            for (int i = 0; i < 4; ++i) { S[i] += b0[i] * LOG2E; S[4 + i] += b1[i] * LOG2E; }
#pragma unroll
            for (int i = 8; i < 16; ++i) S[i] = -1e30f;
            osm_lazy2(S, cm[0], cm[1], l, O, true);
            const bf16x8 pf0 = pack_p(S, 0);
#pragma unroll
            for (int dt = 0; dt < 2; ++dt) O[dt] = __builtin_amdgcn_mfma_f32_32x32x16_bf16(*(const bf16x8*)(vh + (size_t)(dt * 32) * MTOK), pf0, O[dt], 0, 0, 0);
        }
        *(u32x4*)(smem + skey * ATT_ROWB + sch * 16) = kr; *(u32x4*)(smem + ATT_KB + skey * ATT_ROWB + sch * 16) = vr;
        __syncthreads();
        const float* tp = tbl + (hd * 465 + 8 * h - c + 15);
        for (int jj = 0; jj < nrows; ++jj) {
            const int j = jlo + jj, buf = jj & 1;
            if (jj + 1 < nrows) { const int krow0 = b * 4096 + (j + 1) * 64;
                kr = *(const u32x4*)(kbase + (size_t)(krow0 + skey) * 2048); vr = *(const u32x4*)(vbase + krow0); }
            if (j >= rs && j < rs + 8) {
                const unsigned char* Kb = smem + buf * ATT_BUF; const unsigned char* Vb = Kb + ATT_KB;
                const float* tpi = tp + 31 * (j - rg + 7);
                bf16x8 kf[2][4], vf[2][2][2];
#pragma unroll
                for (int tl = 0; tl < 2; ++tl) {
#pragma unroll
                    for (int s = 0; s < 4; ++s) kf[tl][s] = *(const bf16x8*)(Kb + (tl * 32 + kapr) * ATT_ROWB + (16 * s + 8 * h) * 2);
#pragma unroll
                    for (int dt = 0; dt < 2; ++dt)
#pragma unroll
                        for (int s2 = 0; s2 < 2; ++s2) vf[tl][dt][s2] = *(const bf16x8*)(Vb + (dt * 32 + r) * ATT_ROWB + (tl * 32 + 16 * s2 + 8 * h) * 2);
                }
                f32x16 S0 = __builtin_amdgcn_mfma_f32_32x32x16_bf16(kf[0][0], qf[0], cm[0], 0, 0, 0);
                f32x16 S1 = __builtin_amdgcn_mfma_f32_32x32x16_bf16(kf[1][0], qf[0], cm[1], 0, 0, 0);
#pragma unroll
                for (int s = 1; s < 4; ++s) { S0 = __builtin_amdgcn_mfma_f32_32x32x16_bf16(kf[0][s], qf[s], S0, 0, 0, 0); S1 = __builtin_amdgcn_mfma_f32_32x32x16_bf16(kf[1][s], qf[s], S1, 0, 0, 0); }
#pragma unroll
                for (int i = 0; i < 16; ++i) { const int kq0 = 16 * (i >> 3) + (i & 7); S0[i] += tpi[kq0]; S1[i] += tpi[32 + kq0]; }
                osm_lazy_pair2(S0, S1, cm[0], cm[1], l, O);
                { const bf16x8 p00 = pack_p(S0, 0), p01 = pack_p(S0, 1), p10 = pack_p(S1, 0), p11 = pack_p(S1, 1);
#pragma unroll
                  for (int dt = 0; dt < 2; ++dt) { O[dt] = __builtin_amdgcn_mfma_f32_32x32x16_bf16(vf[0][dt][0], p00, O[dt], 0, 0, 0);
                      O[dt] = __builtin_amdgcn_mfma_f32_32x32x16_bf16(vf[0][dt][1], p01, O[dt], 0, 0, 0);
                      O[dt] = __builtin_amdgcn_mfma_f32_32x32x16_bf16(vf[1][dt][0], p10, O[dt], 0, 0, 0);
                      O[dt] = __builtin_amdgcn_mfma_f32_32x32x16_bf16(vf[1][dt][1], p11, O[dt], 0, 0, 0); } }
            }
            if (jj + 1 < nrows) { const int nb = buf ^ 1;
                *(u32x4*)(smem + nb * ATT_BUF + skey * ATT_ROWB + sch * 16) = kr; *(u32x4*)(smem + nb * ATT_BUF + ATT_KB + skey * ATT_ROWB + sch * 16) = vr; }
            __syncthreads();
        }
        const float lt = l + __shfl_xor(l, 32), inv = 1.0f / lt;
        bf16_t* op = o + (size_t)qrow * DM + hd * 64 + 4 * h;
#pragma unroll
        for (int dt = 0; dt < 2; ++dt)
#pragma unroll
            for (int g = 0; g < 4; ++g) { const unsigned w0_ = pk2(O[dt][4 * g] * inv, O[dt][4 * g + 1] * inv), w1_ = pk2(O[dt][4 * g + 2] * inv, O[dt][4 * g + 3] * inv);
                *(unsigned long long*)(op + 32 * dt + 8 * g) = (unsigned long long)w0_ | ((unsigned long long)w1_ << 32); }
    }
    for (int u = vb * 8 + wave; u < 256; u += G * 8) {
        const int hd = u & 15, b = u >> 4;
        const int qrow = MREAL + b * 16 + (r & 15);
        f32x16 O[2], negm; float l = 0.f;
#pragma unroll
        for (int i = 0; i < 16; ++i) negm[i] = 0.f;
#pragma unroll
        for (int dt = 0; dt < 2; ++dt)
#pragma unroll
            for (int i = 0; i < 16; ++i) O[dt][i] = 0.f;
        const bf16_t* qp = qk + (size_t)qrow * 2048 + hd * 64 + 8 * h;
        const bf16_t* kp = qk + (size_t)(MREAL + b * 16 + (kapr & 15)) * 2048 + 1024 + hd * 64 + 8 * h;
        const bf16_t* vh = vt + (size_t)(hd * 64 + r) * MTOK + (MREAL + b * 16 + 8 * h);
        f32x16 S = __builtin_amdgcn_mfma_f32_32x32x16_bf16(*(const bf16x8*)(kp), *(const bf16x8*)(qp), negm, 0, 0, 0);
#pragma unroll
        for (int s = 1; s < 4; ++s) S = __builtin_amdgcn_mfma_f32_32x32x16_bf16(*(const bf16x8*)(kp + 16 * s), *(const bf16x8*)(qp + 16 * s), S, 0, 0, 0);
#pragma unroll
        for (int i = 8; i < 16; ++i) S[i] = -1e30f;
        osm_lazy(S, negm, l, O, true);
        const bf16x8 pf0 = pack_p(S, 0);
#pragma unroll
        for (int dt = 0; dt < 2; ++dt) O[dt] = __builtin_amdgcn_mfma_f32_32x32x16_bf16(*(const bf16x8*)(vh + (size_t)(dt * 32) * MTOK), pf0, O[dt], 0, 0, 0);
        const float lt = l + __shfl_xor(l, 32);
        if (r < 16) {
            const float inv = 1.0f / lt;
            bf16_t* op = o + (size_t)qrow * DM + hd * 64 + 4 * h;
#pragma unroll
            for (int dt = 0; dt < 2; ++dt)
#pragma unroll
                for (int g = 0; g < 4; ++g) { const unsigned w0_ = pk2(O[dt][4 * g] * inv, O[dt][4 * g + 1] * inv), w1_ = pk2(O[dt][4 * g + 2] * inv, O[dt][4 * g + 3] * inv);
                    *(unsigned long long*)(op + 32 * dt + 8 * g) = (unsigned long long)w0_ | ((unsigned long long)w1_ << 32); }
        }
    }
}

#define LAS __attribute__((address_space(3)))
#define XB_TMO      128
#define XB_XCNT(j)  (256  + 64 * (j))
#define XB_XSUB(j)  (1280 + 64 * (j))
#define XB_XGEN(j)  (2304 + 64 * (j))
#define XB_TOP      3328
#define XB_TOPGEN   3392
#define XCD_BAR_WORDS 3456
#define XB_SPIN_CAP (1u << 18)

__device__ __forceinline__ unsigned xb_ld(unsigned* p)              { return __hip_atomic_load(p, __ATOMIC_RELAXED, __HIP_MEMORY_SCOPE_AGENT); }
__device__ __forceinline__ unsigned xb_add(unsigned* p, unsigned v) { return __hip_atomic_fetch_add(p, v, __ATOMIC_RELAXED, __HIP_MEMORY_SCOPE_AGENT); }
__device__ __forceinline__ unsigned xb_xcc_id() { return (unsigned)__builtin_amdgcn_s_getreg((3 << 11) | 20) & 0xFu; }
#define XB_SPIN(cond, bar) do { unsigned _sp = 0; while (cond) { __builtin_amdgcn_s_sleep(1); \
    if ((++_sp & 255u) == 0u) { if (xb_ld(&(bar)[XB_TMO])) break; if (_sp > XB_SPIN_CAP) { atomicAdd(&(bar)[XB_TMO], 1u); break; } } } } while (0)

struct XcdBarrier {
    unsigned* bar; unsigned x;
    volatile LAS unsigned* st;
};

__device__ __forceinline__ XcdBarrier xcd_barrier_post(unsigned* bar, volatile LAS unsigned* st) {
    XcdBarrier b; b.bar = bar; b.x = xb_xcc_id(); b.st = st;
    if (threadIdx.x == 0) (void)xb_add(&bar[XB_XCNT(b.x)], 1u);
    return b;
}
__device__ __forceinline__ void xcd_barrier_complete(unsigned* bar, unsigned x, unsigned& nloc, unsigned& nx) {
    const unsigned G = gridDim.x * gridDim.y * gridDim.z;
    unsigned sum, cnt, mine, sp = 0u;
    for (;;) {
        sum = 0u; cnt = 0u; mine = 0u;
#pragma unroll
        for (unsigned j = 0; j < 16; ++j) { const unsigned c = xb_ld(&bar[XB_XCNT(j)]); sum += c; cnt += (c > 0u) ? 1u : 0u; mine = (j == x) ? c : mine; }
        if (sum == G) break;
        __builtin_amdgcn_s_sleep(1);
        if ((++sp & 255u) == 0u) { if (xb_ld(&bar[XB_TMO])) break; if (sp > XB_SPIN_CAP) { atomicAdd(&bar[XB_TMO], 1u); break; } }
    }
    nloc = mine > 0u ? mine : 1u; nx = cnt > 0u ? cnt : 1u;
}

__device__ __forceinline__ void xcd_barrier(const XcdBarrier& b) {
    asm volatile("s_waitcnt vmcnt(0)" ::: "memory");
    __syncthreads();
    if (threadIdx.x == 0) {
        unsigned* bar = b.bar;
        __builtin_amdgcn_s_waitcnt(0);
        unsigned nloc = b.st[0], nx = b.st[1];
        if (nloc == 0u) { xcd_barrier_complete(bar, b.x, nloc, nx); b.st[0] = nloc; b.st[1] = nx; }
        const unsigned old = xb_add(&bar[XB_XSUB(b.x)], 1u);
        const unsigned gen = old / nloc;
        if (old + 1u == (gen + 1u) * nloc) {
            __builtin_amdgcn_fence(__ATOMIC_RELEASE, "agent");
            asm volatile("s_waitcnt vmcnt(0)" ::: "memory");
            const unsigned og = xb_add(&bar[XB_TOP], 1u);
            const unsigned tg = og / nx;
            if (og + 1u == (tg + 1u) * nx) xb_add(&bar[XB_TOPGEN], 1u);
            else XB_SPIN(xb_ld(&bar[XB_TOPGEN]) == tg, bar);
            __builtin_amdgcn_fence(__ATOMIC_ACQUIRE, "agent");
            xb_add(&bar[XB_XGEN(b.x)], 1u);
            asm volatile("s_waitcnt vmcnt(0)" ::: "memory");
        } else {
            XB_SPIN(xb_ld(&bar[XB_XGEN(b.x)]) == gen, bar);
            __builtin_amdgcn_fence(__ATOMIC_ACQUIRE, "agent");
            asm volatile("s_waitcnt vmcnt(0)" ::: "memory");
        }
    }
    __syncthreads();
}

#if MK_ONE_LAUNCH
#define GRID_SYNC() do { XcdBarrier xb_; xb_.bar = (unsigned*)P.ws; xb_.x = xb_xcc_id(); xb_.st = (volatile LAS unsigned*)(lds + XB_LDS_OFF); xcd_barrier(xb_); } while (0)
#else
#define GRID_SYNC() do {} while (0)
#endif
constexpr int XB_LDS_OFF = 131072;
constexpr size_t XB_WS_BYTES = 16384;
constexpr int N_PHASES = 21;
__global__ void __launch_bounds__(NTHREADS, 2) mk_fwd(Params P) {
    extern __shared__ __attribute__((aligned(16))) unsigned char smem[];
    PG8_LAS unsigned char* lds = (PG8_LAS unsigned char*)smem;
    const int G = gridDim.x, bx = blockIdx.x;
#if MK_ONE_LAUNCH
    if (threadIdx.x == 0) { ((volatile LAS unsigned*)(lds + XB_LDS_OFF))[0] = 0u; ((volatile LAS unsigned*)(lds + XB_LDS_OFF))[1] = 0u; }
    if (blockIdx.x == 0) for (int i = threadIdx.x; i < XCD_BAR_WORDS; i += NTHREADS) ((unsigned*)P.ws)[i] = 0u;
    __syncthreads();
#endif
    if (P.ph_lo == 0) {
        int tid = threadIdx.x; asm volatile("" : "+v"(tid));
        p0_weights(P, smem, tid);
        nr_phase(P, true, false, false, false, 0.f, P.in[2], P.in[2], tid);
#if MK_ONE_LAUNCH
        if (1 < P.ph_hi) cg::this_grid().sync();
        (void)xcd_barrier_post((unsigned*)P.ws, (volatile LAS unsigned*)(lds + XB_LDS_OFF));
#endif
    }
    for (int ph = (P.ph_lo == 0 ? 1 : P.ph_lo); ph < P.ph_hi; ++ph) {
        int tid = threadIdx.x; asm volatile("" : "+v"(tid));
        unsigned char* ws = P.ws; asm volatile("" : "+s"(ws));
        unsigned char* W = ws + WS_W;
        bf16_t* xn = (bf16_t*)(ws + WS_XN); bf16_t* yb = (bf16_t*)(ws + WS_Y); bf16_t* big = (bf16_t*)(ws + WS_BIG); bf16_t* vt = (bf16_t*)(ws + WS_VT);
        float* ssqp = (float*)(ws + WS_SSQ);
        const float* gains = P.in[2];
        {
            const int l = (ph - 1) / 10, s = (ph - 1) % 10;
            const float* gl = gains + (size_t)l * 6 * DM;
            if (s == 0 || s == 7) {
                const int lj = l * 2 + (s == 7);
                pg8::Gemm g{xn, (const bf16_t*)(W + lj * W_FFN_BYTES), MTOK, 2 * FF, DM}; pg8::StaticOrder S; S.init(MTOK, 2 * FF, G, bx);
                EpiSwiGLU E{big};
                pg8::gemm_phase<EpiSwiGLU, pg8::StaticOrder, true, true>(lds, g, S, E, tid);
            } else if (s == 1 || s == 5 || s == 8) {
                pg8::Gemm g; g.M = MREAL; g.N = DM;
                if (s == 5) { g.A = (const bf16_t*)(ws + WS_H); g.Bt = (const bf16_t*)(W + (l == 0 ? W_NA_O : W_GQA_O)); g.K = DM; }
                else { g.A = big; g.Bt = (const bf16_t*)(W + (l * 2 + (s == 8)) * W_FFN_BYTES + W_GU_BYTES); g.K = FF; }
                pg8::StaticOrder S; S.init(MREAL, DM, G, bx);
                EpiY E{yb, ssqp};
                pg8::gemm_phase<EpiY, pg8::StaticOrder, true, true>(lds, g, S, E, tid);
                { int tid2 = threadIdx.x; asm volatile("" : "+v"(tid2));
                  meta_gemm_y(g.A, g.Bt, g.K, yb, ssqp, smem, tid2); }
            } else if (s == 2) nr_phase(P, l == 0, true, true, false, 0.5f, gl + 1 * DM, gl + 2 * DM, tid);
            else if (s == 6) nr_phase(P, false, true, true, false, 1.0f, gl + 3 * DM, gl + 4 * DM, tid);
            else if (s == 9) nr_phase(P, false, true, true, l == 1, 0.5f, gl + 5 * DM, gains + (size_t)((l + 1) % 2) * 6 * DM, tid);
            else if (s == 3) {
                const float* rc = (const float*)(ws + WS_ROPE);
                if (l == 0) {
                    pg8::Gemm g{xn, (const bf16_t*)(W + W_NA_QK), MTOK, 2048, DM}; pg8::StaticOrder S; S.init(MTOK, 2048, G, bx);
                    EpiQK<false> E{big, 2048, 0.125f * LOG2E, nullptr, nullptr, nullptr, nullptr};
                    pg8::gemm_phase<EpiQK<false>, pg8::StaticOrder, true, true>(lds, g, S, E, tid);
                } else {
                    pg8::Gemm g{xn, (const bf16_t*)(W + W_GQA_QK), MTOK, 1280, DM}; pg8::StaticOrder S; S.init(MTOK, 1280, G, bx);
                    EpiQK<true> E{big, 1280, 0.125f * LOG2E, P.in[12], P.in[13], rc, rc + 1024};
                    pg8::gemm_phase<EpiQK<true>, pg8::StaticOrder, true, true>(lds, g, S, E, tid);
                }
                { const int mv = (l == 0) ? 1024 : 256;
                  int tid = threadIdx.x; asm volatile("" : "+v"(tid));
                  pg8::Gemm g{(const bf16_t*)(W + (l == 0 ? W_NA_V : W_GQA_V)), xn, mv, MTOK, DM}; pg8::StaticOrder S; S.init(mv, MTOK, G, bx);
                  EpiPlain E{vt, (size_t)MTOK};
                  pg8::gemm_phase<EpiPlain, pg8::StaticOrder, true, true>(lds, g, S, E, tid); }
            } else {

#ifndef NO_ATTN
                if (l == 0) {
#if NA_FAST
                    na_attn_fast(P, smem, tid);
#else
                    na_attn_naive(P, tid);
#endif
                } else {
#if GQA_FAST
                    {
                        const int ln = tid & 63;
                        float gq = fabsf(P.in[12][ln]), gk = fabsf(P.in[13][ln]);
#pragma unroll
                        for (int o = 32; o >= 1; o >>= 1) { gq = fmaxf(gq, __shfl_xor(gq, o)); gk = fmaxf(gk, __shfl_xor(gk, o)); }
                        const float bnd = 8.0f * LOG2E * gq * gk * 1.02f + 0.5f;
                        if (bnd < 50.0f) gqa_attn_fast<true>(P, smem, tid, bnd); else gqa_attn_fast<false>(P, smem, tid, 0.f);
                    }
#else
                    gqa_attn_naive(P, tid);
#endif
                }
#endif

            }
        }
        if (ph + 1 < P.ph_hi) GRID_SYNC();
    }
}

extern "C" void kernel_launch(void* const* d_in, const int* in_sizes, int n_in, void* d_out, int out_size, void* d_ws, size_t ws_size, hipStream_t stream) {
    static int grid = 0;
    if (grid == 0) {
        if (n_in != 14 || out_size != MREAL * DM || ws_size < WS_END) { fprintf(stderr, "kernel_launch: unexpected shapes (n_in %d out %d ws %zu)\n", n_in, out_size, ws_size); grid = -1; return; }
        int dev = 0, cus = 0, per_cu = 0;
        hipGetDevice(&dev); hipDeviceGetAttribute(&cus, hipDeviceAttributeMultiprocessorCount, dev);
        if (hipFuncSetAttribute((const void*)mk_fwd, hipFuncAttributeMaxDynamicSharedMemorySize, LDS_BYTES) != hipSuccess) { fprintf(stderr, "kernel_launch: hipFuncSetAttribute failed\n"); grid = -1; return; }
        if (hipOccupancyMaxActiveBlocksPerMultiprocessor(&per_cu, (const void*)mk_fwd, NTHREADS, LDS_BYTES) != hipSuccess || per_cu < 1) { fprintf(stderr, "kernel_launch: occupancy query gave %d\n", per_cu); per_cu = 1; }
        (void)hipGetLastError();
        grid = cus * per_cu;
    }
    if (grid < 0) return;
    Params p{};
    for (int i = 0; i < 14; ++i) p.in[i] = (const float*)d_in[i];
    p.out = (float*)d_out; p.ws = (unsigned char*)d_ws;
#if MK_ONE_LAUNCH
    p.ph_lo = 0; p.ph_hi = N_PHASES;
    void* args[] = {&p};
    hipError_t e = hipLaunchCooperativeKernel((const void*)mk_fwd, dim3(grid), dim3(NTHREADS), args, LDS_BYTES, stream);
    if (e != hipSuccess) fprintf(stderr, "cooperative launch failed: %s (grid %d)\n", hipGetErrorString(e), grid);
#else
    for (int ph = 0; ph < N_PHASES; ++ph) {
        p.ph_lo = ph; p.ph_hi = ph + 1;
        for (int rep = 0; rep < (int)((DUP_MASK >> ph) & 1u) + 1; ++rep)
            hipLaunchKernelGGL(mk_fwd, dim3(grid), dim3(NTHREADS), LDS_BYTES, stream, p);
    }
#endif
}
```

```cpp
#include <hip/hip_runtime.h>
#include <hip/hip_cooperative_groups.h>
#include <cstdio>
#include <cstdint>
namespace cg = cooperative_groups;
#ifndef MK_ONE_LAUNCH
#define MK_ONE_LAUNCH 1
#endif
#ifndef NA_FAST
#define NA_FAST 1
#endif
#ifndef GQA_FAST
#define GQA_FAST 1
#endif
#ifndef DUP_MASK
#define DUP_MASK 0u
#endif
#ifndef DUP_VARIANT
#define DUP_VARIANT 0
#endif
namespace pg8 {
#define PG8_LAS __attribute__((address_space(3)))
typedef unsigned short bf16_t;
typedef short bf16x8 __attribute__((ext_vector_type(8)));
typedef float f32x4 __attribute__((ext_vector_type(4)));
typedef unsigned u32x4 __attribute__((ext_vector_type(4)));
constexpr int BM = 256, BK = 64, HALF = 128, HTB = HALF * BK * 2  , STAGE_BYTES = 8 * HTB, NXCD = 8, WGM = 8;

__host__ __device__ __forceinline__ int lds_byte(int r, int c) { const int st = (r >> 4) * 2 + (c >> 5), rr = r & 15, cc = c & 31, ob = rr * 64 + cc * 2; return st * 1024 + (ob ^ (((ob >> 9) & 1) << 5)); }
__host__ __device__ __forceinline__ void stage_rc(int b, int& R, int& C) { const int st = b / 1024, sb = b % 1024, swz = sb ^ (((sb >> 9) & 1) << 5); R = (st >> 1) * 16 + swz / 64; C = (st & 1) * 32 + (swz % 64) / 2; }
__host__ __device__ __forceinline__ int perm32(int rho) { const int n = rho >> 4, i = rho & 15; return 8 * (i >> 2) + 4 * n + (i & 3); }

struct Unit { int pm, pn; };
struct Gemm { const bf16_t* A; const bf16_t* Bt; int M, N, K; };

struct StaticOrder {
    int nM, nN, nwg, G, c;
    __host__ __device__ void init(int M, int N, int G_, int c_) { nM = M / BM; nN = N / BM; nwg = nM * nN; G = G_; c = c_; }
    __host__ __device__ bool next(int i, Unit& u) const {
        const long L = (long)i * G + c; if (L >= nwg) return false;
        int wgid = (int)L; { const int q = nwg / NXCD, r = nwg % NXCD, xcd = wgid % NXCD, off = wgid / NXCD; wgid = (xcd < r ? xcd * (q + 1) : r * (q + 1) + (xcd - r) * q) + off; }
        const int nig = WGM * nN, gid = wgid / nig, fm = gid * WGM, gsz = (nM - fm) < WGM ? (nM - fm) : WGM;
        u.pm = fm + ((wgid % nig) % gsz); u.pn = (wgid % nig) / gsz; return true;
    }
    __device__ __forceinline__ void a_ready(const Unit&) const {}
    __device__ __forceinline__ void done(const Unit&) const {}
};

__device__ __forceinline__ unsigned cvt_pk_bf16(float lo, float hi) { unsigned r; asm volatile("v_cvt_pk_bf16_f32 %0, %1, %2" : "=v"(r) : "v"(lo), "v"(hi)); return r; }
template <class Epi, class Sched, bool ALIGN_EPI = false, bool SP2 = false>
__device__ __forceinline__ void gemm_phase(PG8_LAS unsigned char* lds, const Gemm g, const Sched& S, const Epi& E, const int tid) {
    const int wid = __builtin_amdgcn_readfirstlane(tid >> 6), lane = tid & 63, wr = wid >> 2, wc = wid & 3, fr = lane & 15, fq = lane >> 4;
    const int K = g.K, nt = K / BK;
    unsigned voffA[2], voffB[2];
#pragma unroll
    for (int i = 0; i < 2; ++i) { int R, C; stage_rc(tid * 16 + i * 8192, R, C); const int Rb = Epi::PERM ? ((R & ~31) + perm32(R & 31)) : R;
        voffA[i] = (unsigned)(R * K + C) * 2u; voffB[i] = (unsigned)(Rb * K + C) * 2u; }
    const size_t kstep = (size_t)(BK * 2);
    const size_t hstep = (size_t)HALF * K * 2;
    const size_t tstep = 2 * hstep;
    const unsigned ldsw = (unsigned)wid * 1024u;
    const int aoff = lds_byte(wr * 64 + fr, fq * 8), boff = lds_byte(wc * 32 + fr, fq * 8);
#define PG8_SA(b, h) (((b) * 2 + (h)) * HTB)
#define PG8_SB(b, h) ((4 + (b) * 2 + (h)) * HTB)
#define PG8_STAGE(bufoff, gbase, voff) do { _Pragma("unroll") for (int _i = 0; _i < 2; ++_i) \
        __builtin_amdgcn_global_load_lds((const unsigned*)((const char*)(gbase) + (voff)[_i]), (PG8_LAS unsigned*)(lds + (bufoff) + ldsw + _i * 8192), 16, 0, 0); } while (0)
#define PG8_LDA(dst, b, h) do { _Pragma("unroll") for (int m = 0; m < 4; ++m) _Pragma("unroll") for (int k = 0; k < 2; ++k) dst[m][k] = *(const PG8_LAS bf16x8*)(lds + PG8_SA(b, h) + aoff + m * 2048 + k * 1024); } while (0)
#define PG8_LDB(dst, b, h) do { _Pragma("unroll") for (int n = 0; n < 2; ++n) _Pragma("unroll") for (int k = 0; k < 2; ++k) dst[n][k] = *(const PG8_LAS bf16x8*)(lds + PG8_SB(b, h) + boff + n * 2048 + k * 1024); } while (0)
#define PG8_MMA(ai, bj, At, Bt) do { __builtin_amdgcn_s_setprio(1); _Pragma("unroll") for (int m = 0; m < 4; ++m) _Pragma("unroll") for (int n = 0; n < 2; ++n) _Pragma("unroll") for (int k = 0; k < 2; ++k) \
        acc[ai][bj][m][n] = __builtin_amdgcn_mfma_f32_16x16x32_bf16(Bt[n][k], At[m][k], acc[ai][bj][m][n], 0, 0, 0); __builtin_amdgcn_s_setprio(0); } while (0)
#define PG8_WAIT_V(n) asm volatile("s_waitcnt vmcnt(" #n ")" ::: "memory")
#define PG8_WAIT_L(n) asm volatile("s_waitcnt lgkmcnt(" #n ")" ::: "memory")
#define PG8_BAR __builtin_amdgcn_s_barrier()
#define PG8_SCHED __builtin_amdgcn_sched_barrier(0)
    Unit cur, nxt; int ui = 0;
    if (!S.next(0, cur)) return;
    f32x4 acc[2][2][4][2];
#pragma unroll
    for (int a = 0; a < 2; ++a)
#pragma unroll
        for (int b = 0; b < 2; ++b)
#pragma unroll
            for (int m = 0; m < 4; ++m)
#pragma unroll
                for (int n = 0; n < 2; ++n) acc[a][b][m][n] = (f32x4){0.f, 0.f, 0.f, 0.f};
    bf16x8 At[4][2], B0[2][2], B1[2][2];
    const char* cA = (const char*)g.A + (size_t)cur.pm * tstep; const char* cB = (const char*)g.Bt + (size_t)cur.pn * tstep;
    S.a_ready(cur);
    if constexpr (SP2) {
        PG8_STAGE(PG8_SB(0, 0), cB, voffB); PG8_STAGE(PG8_SB(0, 1), cB + hstep, voffB); PG8_STAGE(PG8_SA(0, 0), cA, voffA); PG8_STAGE(PG8_SA(0, 1), cA + hstep, voffA);
        if (wr == 1) PG8_BAR;
        PG8_WAIT_V(2); PG8_BAR;
        PG8_STAGE(PG8_SB(1, 0), cB + kstep, voffB); PG8_STAGE(PG8_SA(1, 0), cA + kstep, voffA); PG8_STAGE(PG8_SB(1, 1), cB + hstep + kstep, voffB);
        PG8_WAIT_V(6); PG8_BAR;
    } else {
        PG8_STAGE(PG8_SB(0, 0), cB, voffB); PG8_STAGE(PG8_SA(0, 0), cA, voffA); PG8_STAGE(PG8_SB(0, 1), cB + hstep, voffB); PG8_STAGE(PG8_SA(0, 1), cA + hstep, voffA);
        if (wr == 1) PG8_BAR;
        PG8_WAIT_V(4); PG8_BAR;
        PG8_STAGE(PG8_SB(1, 0), cB + kstep, voffB); PG8_STAGE(PG8_SA(1, 0), cA + kstep, voffA); PG8_STAGE(PG8_SB(1, 1), cB + hstep + kstep, voffB);
        PG8_WAIT_V(6); PG8_BAR;
    }
    for (;;) {
        const bool has_next = S.next(ui + 1, nxt);
        const char* nA = has_next ? (const char*)g.A + (size_t)nxt.pm * tstep : cA; const char* nB = has_next ? (const char*)g.Bt + (size_t)nxt.pn * tstep : cB;
        for (int t = 0; t < nt; t += 2) {
            const bool last = (t == nt - 2);
            const char* a1 = cA + (size_t)(t + 1) * kstep;
            const char* a2 = last ? nA : cA + (size_t)(t + 2) * kstep; const char* b2 = last ? nB : cB + (size_t)(t + 2) * kstep;
            const char* a3 = a2 + kstep; const char* b3 = b2 + kstep;
            if (last && has_next) S.a_ready(nxt);
            if constexpr (SP2) {
            PG8_LDB(B0, 0, 0); PG8_LDB(B1, 0, 1); PG8_SCHED; PG8_LDA(At, 0, 0); PG8_STAGE(PG8_SA(1, 1), a1 + hstep, voffA);
            PG8_WAIT_V(8); PG8_WAIT_L(0); PG8_BAR; PG8_MMA(0, 0, At, B0); PG8_MMA(0, 1, At, B1); PG8_BAR; PG8_SCHED;
            PG8_LDA(At, 0, 1); PG8_STAGE(PG8_SB(0, 0), b2, voffB); PG8_STAGE(PG8_SB(0, 1), b2 + hstep, voffB); PG8_STAGE(PG8_SA(0, 0), a2, voffA);
            PG8_WAIT_V(8); PG8_WAIT_L(0); PG8_BAR; PG8_MMA(1, 0, At, B0); PG8_MMA(1, 1, At, B1); PG8_BAR; PG8_SCHED;
            PG8_LDB(B0, 1, 0); PG8_LDB(B1, 1, 1); PG8_SCHED; PG8_LDA(At, 1, 0); PG8_STAGE(PG8_SA(0, 1), a2 + hstep, voffA);
            PG8_WAIT_V(8); PG8_WAIT_L(0); PG8_BAR; PG8_MMA(0, 0, At, B0); PG8_MMA(0, 1, At, B1); PG8_BAR; PG8_SCHED;
            PG8_LDA(At, 1, 1); PG8_STAGE(PG8_SB(1, 0), b3, voffB); PG8_STAGE(PG8_SB(1, 1), b3 + hstep, voffB); PG8_STAGE(PG8_SA(1, 0), a3, voffA);
            PG8_WAIT_V(8); PG8_WAIT_L(0); PG8_BAR; PG8_MMA(1, 0, At, B0); PG8_MMA(1, 1, At, B1); PG8_BAR; PG8_SCHED;
            } else {
            PG8_LDB(B0, 0, 0); PG8_SCHED; PG8_LDA(At, 0, 0); PG8_STAGE(PG8_SA(1, 1), a1 + hstep, voffA);
            PG8_WAIT_L(8); PG8_BAR; PG8_WAIT_L(0); PG8_MMA(0, 0, At, B0); PG8_BAR; PG8_SCHED;
            PG8_LDB(B1, 0, 1); PG8_STAGE(PG8_SB(0, 0), b2, voffB);
            PG8_BAR; PG8_WAIT_L(0); PG8_MMA(0, 1, At, B1); PG8_BAR;
            PG8_LDA(At, 0, 1); PG8_STAGE(PG8_SA(0, 0), a2, voffA);
            PG8_BAR; PG8_WAIT_L(0); PG8_MMA(1, 0, At, B0); PG8_BAR; PG8_SCHED;
            PG8_STAGE(PG8_SB(0, 1), b2 + hstep, voffB);
            PG8_WAIT_V(6); PG8_BAR; PG8_MMA(1, 1, At, B1); PG8_BAR;
            PG8_LDB(B0, 1, 0); PG8_SCHED; PG8_LDA(At, 1, 0); PG8_STAGE(PG8_SA(0, 1), a2 + hstep, voffA);
            PG8_WAIT_L(8); PG8_BAR; PG8_WAIT_L(0); PG8_MMA(0, 0, At, B0); PG8_BAR; PG8_SCHED;
            PG8_LDB(B1, 1, 1); PG8_STAGE(PG8_SB(1, 0), b3, voffB);
            PG8_BAR; PG8_WAIT_L(0); PG8_MMA(0, 1, At, B1); PG8_BAR;
            PG8_LDA(At, 1, 1); PG8_STAGE(PG8_SA(1, 0), a3, voffA);
            PG8_BAR; PG8_WAIT_L(0); PG8_MMA(1, 0, At, B0); PG8_BAR; PG8_SCHED;
            PG8_STAGE(PG8_SB(1, 1), b3 + hstep, voffB);
            PG8_WAIT_V(6); PG8_BAR; PG8_MMA(1, 1, At, B1); PG8_BAR;
            }
        }
        if constexpr (ALIGN_EPI) { if (wr == 0) PG8_BAR; }
        if constexpr (!Epi::AFTER_DRAIN) { E(acc, cur, wr, wc, fr, fq); S.done(cur); }
        if (!has_next) break;
#pragma unroll
        for (int a = 0; a < 2; ++a)
#pragma unroll
            for (int b = 0; b < 2; ++b)
#pragma unroll
                for (int m = 0; m < 4; ++m)
#pragma unroll
                    for (int n = 0; n < 2; ++n) acc[a][b][m][n] = (f32x4){0.f, 0.f, 0.f, 0.f};
        cur = nxt; cA = nA; cB = nB; ++ui;
        if constexpr (ALIGN_EPI) { if (wr == 1) PG8_BAR; }
    }
    PG8_WAIT_V(0);
    if constexpr (!ALIGN_EPI) { if (wr == 0) PG8_BAR; }
    PG8_BAR;
    if constexpr (Epi::AFTER_DRAIN) { E.fused(acc, cur, wr, wc, fr, fq, lds, wid, lane); S.done(cur); }
#undef PG8_SA
#undef PG8_SB
#undef PG8_STAGE
#undef PG8_LDA
#undef PG8_LDB
#undef PG8_MMA
#undef PG8_WAIT_V
#undef PG8_WAIT_L
#undef PG8_BAR
#undef PG8_SCHED
}
}

using pg8::bf16_t; using pg8::bf16x8; using pg8::f32x4; using pg8::u32x4; using pg8::Unit;
constexpr int DM = 1024, NB = 16, SEQ = 4096, NMETA = 16, MREAL = NB * SEQ  , MTOK = MREAL + NB * NMETA  ;
constexpr int FF = 2816, NH = 16, HD = 64;
constexpr float EPS = 1e-6f, LOG2E = 1.4426950408889634f;

constexpr size_t MiB = 1u << 20;
constexpr size_t WS_ROPE = 512 * 1024;
constexpr size_t WS_SSQ = 1 * MiB;
constexpr size_t WS_RMS = 6 * MiB;
constexpr size_t WS_W = 8 * MiB;
constexpr size_t W_GU_BYTES = (size_t)2 * FF * DM * 2, W_DN_BYTES = (size_t)DM * FF * 2, W_FFN_BYTES = W_GU_BYTES + W_DN_BYTES;
constexpr size_t W_NA = 4 * W_FFN_BYTES, W_NA_QK = W_NA, W_NA_V = W_NA + (size_t)2048 * DM * 2, W_NA_O = W_NA_V + (size_t)DM * DM * 2;
constexpr size_t W_GQA = W_NA_O + (size_t)DM * DM * 2, W_GQA_QK = W_GQA, W_GQA_V = W_GQA + (size_t)1280 * DM * 2, W_GQA_O = W_GQA_V + (size_t)256 * DM * 2;
constexpr size_t W_END = W_GQA_O + (size_t)DM * DM * 2;
static_assert(W_END <= 88 * MiB, "weights region");
constexpr size_t WS_H = 96 * MiB;
constexpr size_t WS_XN = 353 * MiB;
constexpr size_t WS_Y = 482 * MiB;
constexpr size_t WS_BIG = 611 * MiB;
constexpr size_t WS_VT = WS_BIG + (size_t)MTOK * 2048 * 2;
constexpr size_t WS_END = WS_VT + (size_t)DM * MTOK * 2;
static_assert(WS_END <= 1024 * MiB && WS_BIG + (size_t)MTOK * FF * 2 <= 1024 * MiB, "workspace");
static_assert(WS_H + (size_t)MTOK * DM * 4 <= WS_XN && WS_XN + (size_t)MTOK * DM * 2 <= WS_Y && WS_Y + (size_t)MTOK * DM * 2 <= WS_BIG, "workspace map");

constexpr int LDS_BYTES = 135168;
constexpr int NTHREADS = 512;

struct Params { const float* in[14]; float* out; unsigned char* ws; int ph_lo, ph_hi; };

typedef float f32x2_t __attribute__((ext_vector_type(2)));
typedef __bf16 bf16x2_t __attribute__((ext_vector_type(2)));
__device__ __forceinline__ unsigned pk2(float lo, float hi) { const f32x2_t v = {lo, hi}; const bf16x2_t b = __builtin_convertvector(v, bf16x2_t); return __builtin_bit_cast(unsigned, b); }
__device__ __forceinline__ float bf_lo(unsigned w) { return __uint_as_float(w << 16); }
__device__ __forceinline__ float bf_hi(unsigned w) { return __uint_as_float(w & 0xffff0000u); }
__device__ __forceinline__ float wave_sum(float v) {
#pragma unroll
    for (int o = 32; o >= 1; o >>= 1) v += __shfl_xor(v, o);
    return v;
}

struct EpiSwiGLU {
    static constexpr bool PERM = true, AFTER_DRAIN = false;
    bf16_t* O;
    __device__ __forceinline__ void operator()(const f32x4 (&acc)[2][2][4][2], const Unit& u, int wr, int wc, int fr, int fq) const {
        const int row0 = u.pm * 256 + wr * 64 + fr, col0 = u.pn * 128 + wc * 32 + 8 * fq;
#pragma unroll
        for (int ai = 0; ai < 2; ++ai)
#pragma unroll
            for (int m = 0; m < 4; ++m) {
                bf16_t* p = O + (size_t)(row0 + ai * 128 + m * 16) * FF + col0;
                float h[8];
#pragma unroll
                for (int n = 0; n < 2; ++n)
#pragma unroll
                    for (int e = 0; e < 4; ++e) { const float gneg = acc[ai][0][m][n][e], ups = acc[ai][1][m][n][e];
                        h[n * 4 + e] = gneg * ups * __builtin_amdgcn_rcpf(1.0f + __builtin_amdgcn_exp2f(gneg)); }
                u32x4 w; w.x = pk2(h[0], h[1]); w.y = pk2(h[2], h[3]); w.z = pk2(h[4], h[5]); w.w = pk2(h[6], h[7]);
                *(u32x4*)p = w;
            }
    }
};
struct EpiY {
    static constexpr bool PERM = true, AFTER_DRAIN = false;
    bf16_t* Y; float* ssqp;
    __device__ __forceinline__ void operator()(const f32x4 (&acc)[2][2][4][2], const Unit& u, int wr, int wc, int fr, int fq) const {
        const int row0 = u.pm * 256 + wr * 64 + fr, col0 = u.pn * 256 + wc * 32 + 8 * fq;
#pragma unroll
        for (int ai = 0; ai < 2; ++ai)
#pragma unroll
            for (int m = 0; m < 4; ++m) {
                const int row = row0 + ai * 128 + m * 16; float s = 0.f;
#pragma unroll
                for (int bj = 0; bj < 2; ++bj) { const f32x4 v0 = acc[ai][bj][m][0], v1 = acc[ai][bj][m][1];
                    s += (v0[0] * v0[0] + v0[1] * v0[1]) + (v0[2] * v0[2] + v0[3] * v0[3]) + (v1[0] * v1[0] + v1[1] * v1[1]) + (v1[2] * v1[2] + v1[3] * v1[3]);
                    u32x4 w; w.x = pk2(v0[0], v0[1]); w.y = pk2(v0[2], v0[3]); w.z = pk2(v1[0], v1[1]); w.w = pk2(v1[2], v1[3]);
                    *(u32x4*)(Y + (size_t)row * DM + col0 + bj * 128) = w; }
                s += __shfl_xor(s, 16); s += __shfl_xor(s, 32);
                if (fq == 0) ssqp[(size_t)row * 16 + u.pn * 4 + wc] = s;
            }
    }
};
struct EpiPlain {
    static constexpr bool PERM = true, AFTER_DRAIN = false;
    bf16_t* O; size_t ldc;
    __device__ __forceinline__ void operator()(const f32x4 (&acc)[2][2][4][2], const Unit& u, int wr, int wc, int fr, int fq) const {
        const int row0 = u.pm * 256 + wr * 64 + fr, col0 = u.pn * 256 + wc * 32 + 8 * fq;
#pragma unroll
        for (int ai = 0; ai < 2; ++ai)
#pragma unroll
            for (int m = 0; m < 4; ++m)
#pragma unroll
                for (int bj = 0; bj < 2; ++bj) { const f32x4 v0 = acc[ai][bj][m][0], v1 = acc[ai][bj][m][1];
                    u32x4 w; w.x = pk2(v0[0], v0[1]); w.y = pk2(v0[2], v0[3]); w.z = pk2(v1[0], v1[1]); w.w = pk2(v1[2], v1[3]);
                    *(u32x4*)(O + (size_t)(row0 + ai * 128 + m * 16) * ldc + col0 + bj * 128) = w; }
    }
};
template <bool GQA> struct EpiQK {
    static constexpr bool PERM = true, AFTER_DRAIN = false;
    bf16_t* O; int ldo; float qscale; const float* qgain; const float* kgain; const float* ropec; const float* ropes;
    __device__ __forceinline__ void operator()(const f32x4 (&acc)[2][2][4][2], const Unit& u, int wr, int wc, int fr, int fq) const {
        const bool isq = u.pn < 4; const float sc = isq ? qscale : 1.0f;
        const int colb = 64 * (4 * u.pn + wc) + 8 * fq;
        f32x4 gn[2][2];
        if (GQA) { const float* gp = isq ? qgain : kgain;
#pragma unroll
            for (int bj = 0; bj < 2; ++bj)
#pragma unroll
                for (int n = 0; n < 2; ++n) gn[bj][n] = *(const f32x4*)(gp + 32 * bj + 16 * n + 4 * fq); }
#pragma unroll
        for (int ai = 0; ai < 2; ++ai)
#pragma unroll
            for (int m = 0; m < 4; ++m) {
                const int row = u.pm * 256 + ai * 128 + wr * 64 + m * 16 + fr;
                f32x4 x[2][2];
#pragma unroll
                for (int bj = 0; bj < 2; ++bj)
#pragma unroll
                    for (int n = 0; n < 2; ++n) x[bj][n] = acc[ai][bj][m][n];
                if (GQA) {
                    float s = 0.f;
#pragma unroll
                    for (int bj = 0; bj < 2; ++bj)
#pragma unroll
                        for (int n = 0; n < 2; ++n) s += (x[bj][n][0] * x[bj][n][0] + x[bj][n][1] * x[bj][n][1]) + (x[bj][n][2] * x[bj][n][2] + x[bj][n][3] * x[bj][n][3]);
                    s += __shfl_xor(s, 16); s += __shfl_xor(s, 32);
                    const float rstd = rsqrtf(s * (1.0f / 64.0f) + EPS);
#pragma unroll
                    for (int bj = 0; bj < 2; ++bj)
#pragma unroll
                        for (int n = 0; n < 2; ++n) x[bj][n] = x[bj][n] * rstd * gn[bj][n];
                    if (u.pm < 256) {
                        const int sidx = row & 4095; const int pos[2] = {sidx >> 6, sidx & 63};
#pragma unroll
                        for (int bj = 0; bj < 2; ++bj) {
                            const f32x4 c = *(const f32x4*)(ropec + pos[bj] * 16 + 4 * fq), sn = *(const f32x4*)(ropes + pos[bj] * 16 + 4 * fq);
                            const f32x4 x1 = x[bj][0], x2 = x[bj][1];
                            x[bj][0] = x1 * c - x2 * sn; x[bj][1] = x2 * c + x1 * sn;
                        }
                    }
                }
#pragma unroll
                for (int bj = 0; bj < 2; ++bj) { const f32x4 v0 = x[bj][0] * sc, v1 = x[bj][1] * sc;
                    u32x4 w; w.x = pk2(v0[0], v0[1]); w.y = pk2(v0[2], v0[3]); w.z = pk2(v1[0], v1[1]); w.w = pk2(v1[2], v1[3]);
                    *(u32x4*)(O + (size_t)row * ldo + colb + 32 * bj) = w; }
            }
    }
};


__device__ __forceinline__ void meta_gemm_y(const bf16_t* A, const bf16_t* Wt, const int K, bf16_t* Y, float* ssqp, unsigned char* smem, const int tid) {
    const int wave = tid >> 6, lane = tid & 63, fr = lane & 15, fq = lane >> 4;
    float* red = (float*)smem;
    const int kw = K >> 3;
    for (int su = blockIdx.x; su < 256; su += gridDim.x) {
        const int rt = su >> 4, ct = su & 15;
        const bf16_t* ap = A + (size_t)(MREAL + 16 * rt + fr) * K + wave * kw + 8 * fq;
        const bf16_t* bp = Wt + (size_t)(64 * ct + fr) * K + wave * kw + 8 * fq;
        f32x4 acc[4];
#pragma unroll
        for (int c4 = 0; c4 < 4; ++c4) acc[c4] = (f32x4){0.f, 0.f, 0.f, 0.f};
#pragma unroll 4
        for (int k = 0; k < kw; k += 32) {
            const bf16x8 a = *(const bf16x8*)(ap + k);
#pragma unroll
            for (int c4 = 0; c4 < 4; ++c4) acc[c4] = __builtin_amdgcn_mfma_f32_16x16x32_bf16(a, *(const bf16x8*)(bp + (size_t)(16 * c4) * K + k), acc[c4], 0, 0, 0);
        }
#pragma unroll
        for (int c4 = 0; c4 < 4; ++c4)
#pragma unroll
            for (int i = 0; i < 4; ++i) red[(wave * 16 + 4 * fq + i) * 64 + 16 * c4 + fr] = acc[c4][i];
        __syncthreads();
        const int row = 2 * wave + (lane >> 5), cp = lane & 31;
        float s0 = 0.f, s1 = 0.f;
#pragma unroll
        for (int w = 0; w < 8; ++w) { const f32x2_t v = *(const f32x2_t*)(red + (w * 16 + row) * 64 + 2 * cp); s0 += v.x; s1 += v.y; }
        const int grow = MREAL + 16 * rt + row;
        *(unsigned*)(Y + (size_t)grow * DM + 64 * ct + 2 * cp) = pk2(s0, s1);
        float q = s0 * s0 + s1 * s1;
        q += __shfl_xor(q, 1); q += __shfl_xor(q, 2); q += __shfl_xor(q, 4); q += __shfl_xor(q, 8); q += __shfl_xor(q, 16);
        if (cp == 0) ssqp[(size_t)grow * 16 + ct] = q;
        __syncthreads();
    }
}

__device__ __forceinline__ void p0_weights(const Params& P, unsigned char* smem, const int tid) {
    float* tile = (float*)smem;
    unsigned char* W = P.ws + WS_W;
    for (int job = 0; job < 14; ++job) {
        const float* srcA; const float* srcB = nullptr; int ld, N, K, kind, coloff = 0; bf16_t* dst;
        const float* gk = nullptr;
        if (job < 8) { const int lj = job >> 1, dn = job & 1;
            if (!dn) gk = P.in[2] + (size_t)((lj >> 1) * 6 + ((lj & 1) ? 4 : 0)) * DM;
            if (!dn) { kind = 0; srcA = P.in[3] + (size_t)lj * DM * FF; srcB = P.in[4] + (size_t)lj * DM * FF; ld = FF; N = 2 * FF; K = DM; dst = (bf16_t*)(W + lj * W_FFN_BYTES); }
            else     { kind = 1; srcA = P.in[5] + (size_t)lj * FF * DM; ld = DM; N = DM; K = FF; dst = (bf16_t*)(W + lj * W_FFN_BYTES + W_GU_BYTES); } }
        else if (job == 8)  { gk = P.in[2] + (size_t)(0 * 6 + 2) * DM; kind = 2; srcA = P.in[6];  ld = 3072; N = 2048; K = DM; dst = (bf16_t*)(W + W_NA_QK); }
        else if (job == 9)  { gk = P.in[2] + (size_t)(0 * 6 + 2) * DM; kind = 1; srcA = P.in[6];  ld = 3072; N = 1024; K = DM; coloff = 2048; dst = (bf16_t*)(W + W_NA_V); }
        else if (job == 10) { kind = 1; srcA = P.in[7];  ld = 1024; N = 1024; K = DM; dst = (bf16_t*)(W + W_NA_O); }
        else if (job == 11) { gk = P.in[2] + (size_t)(1 * 6 + 2) * DM; kind = 3; srcA = P.in[10]; ld = 1536; N = 1280; K = DM; dst = (bf16_t*)(W + W_GQA_QK); }
        else if (job == 12) { gk = P.in[2] + (size_t)(1 * 6 + 2) * DM; kind = 1; srcA = P.in[10]; ld = 1536; N = 256;  K = DM; coloff = 1280; dst = (bf16_t*)(W + W_GQA_V); }
        else                { kind = 1; srcA = P.in[11]; ld = 1024; N = 1024; K = DM; dst = (bf16_t*)(W + W_GQA_O); }
        const int ntn = N / 64, ntk = K / 64;
        for (int t = blockIdx.x; t < ntn * ntk; t += gridDim.x) {
            const int n0 = (t % ntn) * 64, k0 = (t / ntn) * 64;
            const int nn = 4 * (tid & 15), p = n0 + nn;
            const float* cp;
            if (kind == 0) { const int bj = (p >> 7) & 1, col = (p >> 8) * 128 + (p & 127); cp = (bj ? srcB : srcA) + col; }
            else if (kind == 1) cp = srcA + coloff + p;
            else { const int c32 = p & 31, wcw = (p >> 5) & 3, bj = (p >> 7) & 1, pn = p >> 8;
                const int d = (kind == 2) ? (32 * bj + c32) : (32 * bj + 16 * ((c32 >> 2) & 1) + 4 * (c32 >> 3) + (c32 & 3));
                cp = srcA + 64 * (4 * pn + wcw) + d; }
            const float wsc = (kind == 0) ? ((((n0 + nn) >> 7) & 1) ? -0.6931471805599453f : -LOG2E) : 1.0f;
#pragma unroll
            for (int i = 0; i < 2; ++i) { const int kk = (tid >> 4) + 32 * i; const float sck = wsc * (gk ? gk[k0 + kk] : 1.0f);
                const f32x4 w4 = __builtin_nontemporal_load((const f32x4*)(cp + (size_t)(k0 + kk) * ld));
                tile[kk * 65 + nn] = w4[0] * sck; tile[kk * 65 + nn + 1] = w4[1] * sck; tile[kk * 65 + nn + 2] = w4[2] * sck; tile[kk * 65 + nn + 3] = w4[3] * sck; }
            __syncthreads();
            const int nn2 = tid >> 3, ks = (tid & 7) * 8;
            float v[8];
#pragma unroll
            for (int e = 0; e < 8; ++e) v[e] = tile[(ks + e) * 65 + nn2];
            u32x4 w; w.x = pk2(v[0], v[1]); w.y = pk2(v[2], v[3]); w.z = pk2(v[4], v[5]); w.w = pk2(v[6], v[7]);
            *(u32x4*)(dst + (size_t)(n0 + nn2) * K + k0 + ks) = w;
            __syncthreads();
        }
    }
    for (int i = blockIdx.x * NTHREADS + tid; i < 1024; i += gridDim.x * NTHREADS) {
        const int pos = i >> 4, f = i & 15;
        const float freq = __builtin_amdgcn_exp2f(-(float)f * (13.287712379549449f / 16.0f));
        const float ang = (float)pos * freq;
        const float kq = rintf(ang * 0.15915494309189535f);
        float r = fmaf(-kq, 6.28318548202514648f, ang); r = fmaf(-kq, -1.74845553e-07f, r);
        ((float*)(P.ws + WS_ROPE))[i] = __cosf(r); ((float*)(P.ws + WS_ROPE))[1024 + i] = __sinf(r);
    }
}

typedef unsigned u32x2 __attribute__((ext_vector_type(2)));
struct NrRow { f32x4 h[4]; u32x4 y[2]; float ss, rms; };
__device__ __forceinline__ void nr_load(NrRow& R, const Params& P, int row, bool src_input, bool has_y, const bf16_t* h, const bf16_t* y, const float* ssqp, int lane) {
    if (src_input) {
        const float* hs = row < MREAL ? P.in[0] + (size_t)row * DM : P.in[1] + (size_t)((row - MREAL) & 15) * DM;
#pragma unroll
        for (int q = 0; q < 2; ++q) { R.h[2 * q] = *(const f32x4*)(hs + 8 * lane + 512 * q); R.h[2 * q + 1] = *(const f32x4*)(hs + 8 * lane + 512 * q + 4); }
    } else {
#pragma unroll
        for (int q = 0; q < 2; ++q) { const u32x4 w = __builtin_nontemporal_load((const u32x4*)(h + (size_t)row * DM + 8 * lane + 512 * q));
            R.h[2 * q] = (f32x4){bf_lo(w.x), bf_hi(w.x), bf_lo(w.y), bf_hi(w.y)}; R.h[2 * q + 1] = (f32x4){bf_lo(w.z), bf_hi(w.z), bf_lo(w.w), bf_hi(w.w)}; }
        R.rms = ((const float*)(P.ws + WS_RMS))[row];
    }
    if (has_y) {
#pragma unroll
        for (int q = 0; q < 2; ++q) R.y[q] = __builtin_nontemporal_load((const u32x4*)(y + (size_t)row * DM + 8 * lane + 512 * q));
        R.ss = ssqp[(size_t)row * 16 + (lane & 15)];
    }
}
__device__ __forceinline__ void nr_phase(const Params& P, bool src_input, bool has_y, bool write_h, bool final_out, float coef, const float* gpost, const float* gpre, const int tid) {
    const int wave = tid >> 6, lane = tid & 63;
    bf16_t* xn = (bf16_t*)(P.ws + WS_XN); bf16_t* h = xn; const bf16_t* y = (const bf16_t*)(P.ws + WS_Y); const float* ssqp = (const float*)(P.ws + WS_SSQ); float* rmsb = (float*)(P.ws + WS_RMS);
    f32x4 gp[4];
#pragma unroll
    for (int q = 0; q < 2; ++q) { gp[2 * q] = *(const f32x4*)(gpost + 8 * lane + 512 * q); gp[2 * q + 1] = *(const f32x4*)(gpost + 8 * lane + 512 * q + 4); }
    const int stride = gridDim.x * 8;
    int row = blockIdx.x * 8 + wave;
    NrRow nx, nx2;
    if (row < MTOK) nr_load(nx, P, row, src_input, has_y, h, y, ssqp, lane);
    if (row + stride < MTOK) nr_load(nx2, P, row + stride, src_input, has_y, h, y, ssqp, lane);
    for (; row < MTOK; row += stride) {
        NrRow cu = nx; nx = nx2;
        if (row + 2 * stride < MTOK) nr_load(nx2, P, row + 2 * stride, src_input, has_y, h, y, ssqp, lane);
        f32x4 v[4];
#pragma unroll
        for (int j = 0; j < 4; ++j) v[j] = src_input ? cu.h[j] : cu.h[j] * cu.rms;
        if (has_y) {
            float ss = cu.ss; ss += __shfl_xor(ss, 1); ss += __shfl_xor(ss, 2); ss += __shfl_xor(ss, 4); ss += __shfl_xor(ss, 8);
            const float sc = coef * rsqrtf(ss * (1.0f / DM) + EPS);
#pragma unroll
            for (int q = 0; q < 2; ++q) { const u32x4 w = cu.y[q];
                v[2 * q] += (f32x4){bf_lo(w.x), bf_hi(w.x), bf_lo(w.y), bf_hi(w.y)} * gp[2 * q] * sc;
                v[2 * q + 1] += (f32x4){bf_lo(w.z), bf_hi(w.z), bf_lo(w.w), bf_hi(w.w)} * gp[2 * q + 1] * sc; }
        }
        if (final_out) {
            if (row < MREAL) { float* o = P.out + (size_t)row * DM;
#pragma unroll
                for (int q = 0; q < 2; ++q) { *(f32x4*)(o + 8 * lane + 512 * q) = v[2 * q]; *(f32x4*)(o + 8 * lane + 512 * q + 4) = v[2 * q + 1]; } }
            continue;
        }
        float s2 = 0.f;
#pragma unroll
        for (int j = 0; j < 4; ++j) s2 += (v[j][0] * v[j][0] + v[j][1] * v[j][1]) + (v[j][2] * v[j][2] + v[j][3] * v[j][3]);
        s2 = wave_sum(s2);
        const float ms = s2 * (1.0f / DM) + EPS, r2 = rsqrtf(ms);
        if (lane == 0) rmsb[row] = ms * r2;
#pragma unroll
        for (int q = 0; q < 2; ++q) { const f32x4 a = v[2 * q] * r2, b = v[2 * q + 1] * r2; u32x4 w; w.x = pk2(a[0], a[1]); w.y = pk2(a[2], a[3]); w.z = pk2(b[0], b[1]); w.w = pk2(b[2], b[3]);
            *(u32x4*)(xn + (size_t)row * DM + 8 * lane + 512 * q) = w; }
    }
}

struct NaiveState { float m, l; float o[64]; };
__device__ __forceinline__ void naive_key(NaiveState& st, const float (&q)[64], const bf16_t* krow, const bf16_t* vcol  , float bias2) {
    float s = bias2;
#pragma unroll
    for (int c = 0; c < 8; ++c) { const u32x4 kw = *(const u32x4*)(krow + 8 * c);
        s += q[8 * c + 0] * bf_lo(kw.x) + q[8 * c + 1] * bf_hi(kw.x) + q[8 * c + 2] * bf_lo(kw.y) + q[8 * c + 3] * bf_hi(kw.y)
           + q[8 * c + 4] * bf_lo(kw.z) + q[8 * c + 5] * bf_hi(kw.z) + q[8 * c + 6] * bf_lo(kw.w) + q[8 * c + 7] * bf_hi(kw.w); }
    const float mn = fmaxf(st.m, s), corr = __builtin_amdgcn_exp2f(st.m - mn), p = __builtin_amdgcn_exp2f(s - mn);
    st.m = mn; st.l = st.l * corr + p;
#pragma unroll
    for (int d = 0; d < 64; ++d) st.o[d] = st.o[d] * corr + p * __uint_as_float((unsigned)vcol[(size_t)d * MTOK] << 16);
}
__device__ __forceinline__ void naive_load_q(float (&q)[64], const bf16_t* qp) {
#pragma unroll
    for (int c = 0; c < 8; ++c) { const u32x4 w = *(const u32x4*)(qp + 8 * c);
        q[8 * c + 0] = bf_lo(w.x); q[8 * c + 1] = bf_hi(w.x); q[8 * c + 2] = bf_lo(w.y); q[8 * c + 3] = bf_hi(w.y);
        q[8 * c + 4] = bf_lo(w.z); q[8 * c + 5] = bf_hi(w.z); q[8 * c + 6] = bf_lo(w.w); q[8 * c + 7] = bf_hi(w.w); }
}
__device__ __forceinline__ void naive_store_o(const NaiveState& st, bf16_t* op) {
    const float inv = 1.0f / st.l;
#pragma unroll
    for (int c = 0; c < 8; ++c) { u32x4 w; w.x = pk2(st.o[8 * c] * inv, st.o[8 * c + 1] * inv); w.y = pk2(st.o[8 * c + 2] * inv, st.o[8 * c + 3] * inv);
        w.z = pk2(st.o[8 * c + 4] * inv, st.o[8 * c + 5] * inv); w.w = pk2(st.o[8 * c + 6] * inv, st.o[8 * c + 7] * inv); *(u32x4*)(op + 8 * c) = w; }
}
__device__ __forceinline__ void na_attn_naive(const Params& P, const int tid) {
    const bf16_t* qk = (const bf16_t*)(P.ws + WS_BIG); const bf16_t* vt = (const bf16_t*)(P.ws + WS_VT); bf16_t* o = (bf16_t*)(P.ws + WS_H);
    const float* rpb = P.in[8]; const float* mbias = P.in[9];
    const int wave = tid >> 6, lane = tid & 63;
    for (int u = blockIdx.x * 8 + wave; u < 16384 + 256; u += gridDim.x * 8) {
        const bool meta = u >= 16384;
        int b, hd, r;
        if (!meta) { hd = u & 15; r = (u >> 4) & 63; b = u >> 10; } else { const int t = u - 16384; hd = t & 15; b = t >> 4; r = 0; }
        if (meta && lane >= 16) continue;
        const int c = lane;
        const int qrow = meta ? MREAL + b * 16 + lane : b * 4096 + r * 64 + c;
        float q[64]; naive_load_q(q, qk + (size_t)qrow * 2048 + hd * 64);
        NaiveState st; st.m = -1e30f; st.l = 0.f;
#pragma unroll
        for (int d = 0; d < 64; ++d) st.o[d] = 0.f;
        const bf16_t* vh = vt + (size_t)(hd * 64) * MTOK;
        for (int j = 0; j < 16; ++j) { const int krow = MREAL + b * 16 + j;
            naive_key(st, q, qk + (size_t)krow * 2048 + 1024 + hd * 64, vh + krow, meta ? 0.f : mbias[hd * 16 + j] * LOG2E); }
        if (!meta) {
            const int rs = min(max(r - 4, 0), 56), cs = min(max(c - 8, 0), 48);
            for (int i = 0; i < 8; ++i)
                for (int j = 0; j < 16; ++j) { const int krow = b * 4096 + (rs + i) * 64 + cs + j;
                    const float bias = rpb[(hd * 15 + (rs + i - r + 7)) * 31 + (cs + j - c + 15)];
                    naive_key(st, q, qk + (size_t)krow * 2048 + 1024 + hd * 64, vh + krow, bias * LOG2E); }
        }
        naive_store_o(st, o + (size_t)qrow * DM + hd * 64);
    }
}
__device__ __forceinline__ void gqa_attn_naive(const Params& P, const int tid) {
    const bf16_t* qk = (const bf16_t*)(P.ws + WS_BIG); const bf16_t* vt = (const bf16_t*)(P.ws + WS_VT); bf16_t* o = (bf16_t*)(P.ws + WS_H);
    const int wave = tid >> 6, lane = tid & 63;
    for (int u = blockIdx.x * 8 + wave; u < 16384 + 256; u += gridDim.x * 8) {
        const bool meta = u >= 16384;
        int b, hd, qb;
        if (!meta) { qb = u & 63; hd = (u >> 6) & 15; b = u >> 10; } else { const int t = u - 16384; hd = t & 15; b = t >> 4; qb = 0; }
        if (meta && lane >= 16) continue;
        const int kvh = hd >> 2;
        const int qrow = meta ? MREAL + b * 16 + lane : b * 4096 + qb * 64 + lane;
        float q[64]; naive_load_q(q, qk + (size_t)qrow * 1280 + hd * 64);
        NaiveState st; st.m = -1e30f; st.l = 0.f;
#pragma unroll
        for (int d = 0; d < 64; ++d) st.o[d] = 0.f;
        const bf16_t* vh = vt + (size_t)(kvh * 64) * MTOK;
        for (int j = 0; j < 4096 + 16; ++j) { const int krow = j < 4096 ? b * 4096 + j : MREAL + b * 16 + (j - 4096);
            naive_key(st, q, qk + (size_t)krow * 1280 + 1024 + kvh * 64, vh + krow, 0.f); }
        naive_store_o(st, o + (size_t)qrow * DM + hd * 64);
    }
}


typedef float f32x16 __attribute__((ext_vector_type(16)));
constexpr int ATT_ROWB = 144, ATT_KB = 64 * ATT_ROWB, ATT_BUF = 2 * ATT_KB;
template <bool FIXEDM> __device__ __forceinline__ void gqa_attn_fast(const Params& P, unsigned char* smem, const int tid, const float bnd) {
    const bf16_t* qk = (const bf16_t*)(P.ws + WS_BIG); const bf16_t* vt = (const bf16_t*)(P.ws + WS_VT); bf16_t* o = (bf16_t*)(P.ws + WS_H);
    const int wave = tid >> 6, lane = tid & 63, r = lane & 31, h = lane >> 5, qsub = wave & 3, hp = wave >> 2;
    const int G = gridDim.x, bx = blockIdx.x;
    const int skey = tid >> 3, sch = tid & 7;
    const int kapr = (r & ~12) | ((r & 4) << 1) | ((r & 8) >> 1);
    const u32x4 zero4 = {0u, 0u, 0u, 0u};
    for (int it = 0;; ++it) {
        const int ulin = it * G + bx;
        if (ulin >= 2048 + 64) break;
        const bool meta = ulin >= 2048;
        int bk, qb;
        if (meta) { bk = ulin - 2048; qb = 0; }
        else if (G == 256) { bk = it * 8 + (bx & 7); qb = bx >> 3; }
        else { bk = ulin >> 5; qb = ulin & 31; }
        const int b = bk >> 2, kvh = bk & 3;
        const int ftile = meta ? qsub : 0;
        const int qrow = meta ? MREAL + b * 16 + (r & 15) : b * 4096 + qb * 128 + qsub * 32 + r;
        bf16x8 qf[2][4];
#pragma unroll
        for (int t = 0; t < 2; ++t)
#pragma unroll
            for (int s = 0; s < 4; ++s) qf[t][s] = *(const bf16x8*)(qk + (size_t)qrow * 1280 + (kvh * 4 + hp * 2 + t) * 64 + 16 * s + 8 * h);
        f32x16 O[2][2], negm[2], L; float l[2];
        const unsigned on0 = (r < 16) ? 0x3f803f80u : 0u, on1 = (r < 16) ? 0u : 0x3f803f80u;
        const u32x4 a0_u = {on0, on0, on0, on0}, a1_u = {on1, on1, on1, on1}; const bf16x8 onesA[2] = {__builtin_bit_cast(bf16x8, a0_u), __builtin_bit_cast(bf16x8, a1_u)};
#pragma unroll
        for (int t = 0; t < 2; ++t) { l[t] = 0.f;
#pragma unroll
            for (int i = 0; i < 16; ++i) { negm[t][i] = FIXEDM ? -bnd : 0.f; L[i] = 0.f; }
#pragma unroll
            for (int dt = 0; dt < 2; ++dt)
#pragma unroll
                for (int i = 0; i < 16; ++i) O[t][dt][i] = 0.f; }
        const bf16_t* kbase = qk + 1024 + kvh * 64 + sch * 8;
        const bf16_t* vbase = vt + (size_t)(kvh * 64 + skey) * MTOK + sch * 8;
        u32x4 kr, vr;
        { const int krow0 = b * 4096;
          kr = *(const u32x4*)(kbase + (size_t)(krow0 + skey) * 1280); vr = *(const u32x4*)(vbase + krow0);
          *(u32x4*)(smem + skey * ATT_ROWB + sch * 16) = kr; *(u32x4*)(smem + ATT_KB + skey * ATT_ROWB + sch * 16) = vr; }
        __syncthreads();
        for (int tile = 0; tile <= 64; ++tile) {
            const int buf = tile & 1;
            if (tile < 64) {
                const int nt = tile + 1;
                if (nt < 64) { const int krow0 = b * 4096 + nt * 64; kr = *(const u32x4*)(kbase + (size_t)(krow0 + skey) * 1280); vr = *(const u32x4*)(vbase + krow0); }
                else { const int krow0 = MREAL + b * 16;
                    kr = skey < 16 ? *(const u32x4*)(kbase + (size_t)(krow0 + skey) * 1280) : zero4;
                    vr = sch < 2 ? *(const u32x4*)(vbase + krow0) : zero4; }
            }
            if (!meta || (tile & 3) == qsub) {
                const unsigned char* Kb = smem + buf * ATT_BUF; const unsigned char* Vb = Kb + ATT_KB;
                if (FIXEDM && tile < 64) {
#pragma unroll
                for (int sub = 0; sub < 2; ++sub) {
                    bf16x8 kf[4], vf[2][2];
#pragma unroll
                    for (int s = 0; s < 4; ++s) kf[s] = *(const bf16x8*)(Kb + (sub * 32 + kapr) * ATT_ROWB + (16 * s + 8 * h) * 2);
#pragma unroll
                    for (int dt = 0; dt < 2; ++dt)
#pragma unroll
                        for (int s2 = 0; s2 < 2; ++s2) vf[dt][s2] = *(const bf16x8*)(Vb + (dt * 32 + r) * ATT_ROWB + (sub * 32 + 16 * s2 + 8 * h) * 2);
#pragma unroll
                    for (int t = 0; t < 2; ++t) {
                        f32x16 S = __builtin_amdgcn_mfma_f32_32x32x16_bf16(kf[0], qf[t][0], negm[FIXEDM ? 0 : t], 0, 0, 0);
#pragma unroll
                        for (int s = 1; s < 4; ++s) S = __builtin_amdgcn_mfma_f32_32x32x16_bf16(kf[s], qf[t][s], S, 0, 0, 0);
                        if (tile == 64) {
#pragma unroll
                            for (int i = 8; i < 16; ++i) S[i] = -1e30f;
                        }
                        if (!FIXEDM) {
                        float mx = fmaxf(fmaxf(S[0], S[1]), S[2]);
#pragma unroll
                        for (int i = 3; i < 15; i += 2) mx = fmaxf(fmaxf(mx, S[i]), S[i + 1]);
                        mx = fmaxf(mx, S[15]);
                        mx = fmaxf(mx, __shfl_xor(mx, 32));
                        const bool first = (tile == ftile) && (sub == 0);
                        if (first || __ballot(mx > 8.0f) != 0ull) {
                            const float d = first ? mx : fmaxf(mx, 0.f), alpha = first ? 1.0f : __builtin_amdgcn_exp2f(-d);
#pragma unroll
                            for (int i = 0; i < 16; ++i) { S[i] -= d; negm[t][i] -= d; }
#pragma unroll
                            for (int i = 0; i < 8; ++i) L[8 * t + i] *= alpha;
#pragma unroll
                            for (int dt = 0; dt < 2; ++dt)
#pragma unroll
                                for (int i = 0; i < 16; ++i) O[t][dt][i] *= alpha;
                        }
                        }
#pragma unroll
                        for (int i = 0; i < 16; ++i) S[i] = __builtin_amdgcn_exp2f(S[i]);
                        bf16x8 pf[2];
#pragma unroll
                        for (int s2 = 0; s2 < 2; ++s2) { u32x4 w; w.x = pk2(S[8 * s2], S[8 * s2 + 1]); w.y = pk2(S[8 * s2 + 2], S[8 * s2 + 3]);
                            w.z = pk2(S[8 * s2 + 4], S[8 * s2 + 5]); w.w = pk2(S[8 * s2 + 6], S[8 * s2 + 7]); pf[s2] = __builtin_bit_cast(bf16x8, w); }
#pragma unroll
                        for (int dt = 0; dt < 2; ++dt)
#pragma unroll
                            for (int s2 = 0; s2 < 2; ++s2) O[t][dt] = __builtin_amdgcn_mfma_f32_32x32x16_bf16(vf[dt][s2], pf[s2], O[t][dt], 0, 0, 0);
                        L = __builtin_amdgcn_mfma_f32_32x32x16_bf16(onesA[t], pf[0], L, 0, 0, 0);
                        L = __builtin_amdgcn_mfma_f32_32x32x16_bf16(onesA[t], pf[1], L, 0, 0, 0);
                    }
                }
                } else {
                const int nsub = tile < 64 ? 2 : 1;
#pragma unroll 1
                for (int sub = 0; sub < nsub; ++sub) {
                    bf16x8 kf[4], vf[2][2];
#pragma unroll
                    for (int s = 0; s < 4; ++s) kf[s] = *(const bf16x8*)(Kb + (sub * 32 + kapr) * ATT_ROWB + (16 * s + 8 * h) * 2);
#pragma unroll
                    for (int dt = 0; dt < 2; ++dt)
#pragma unroll
                        for (int s2 = 0; s2 < 2; ++s2) vf[dt][s2] = *(const bf16x8*)(Vb + (dt * 32 + r) * ATT_ROWB + (sub * 32 + 16 * s2 + 8 * h) * 2);
#pragma unroll
                    for (int t = 0; t < 2; ++t) {
                        f32x16 S = __builtin_amdgcn_mfma_f32_32x32x16_bf16(kf[0], qf[t][0], negm[FIXEDM ? 0 : t], 0, 0, 0);
#pragma unroll
                        for (int s = 1; s < 4; ++s) S = __builtin_amdgcn_mfma_f32_32x32x16_bf16(kf[s], qf[t][s], S, 0, 0, 0);
                        if (tile == 64) {
#pragma unroll
                            for (int i = 8; i < 16; ++i) S[i] = -1e30f;
                        }
                        if (!FIXEDM) {
                        float mx = fmaxf(fmaxf(S[0], S[1]), S[2]);
#pragma unroll
                        for (int i = 3; i < 15; i += 2) mx = fmaxf(fmaxf(mx, S[i]), S[i + 1]);
                        mx = fmaxf(mx, S[15]);
                        mx = fmaxf(mx, __shfl_xor(mx, 32));
                        const bool first = (tile == ftile) && (sub == 0);
                        if (first || __ballot(mx > 8.0f) != 0ull) {
                            const float d = first ? mx : fmaxf(mx, 0.f), alpha = first ? 1.0f : __builtin_amdgcn_exp2f(-d);
#pragma unroll
                            for (int i = 0; i < 16; ++i) { S[i] -= d; negm[t][i] -= d; }
#pragma unroll
                            for (int i = 0; i < 8; ++i) L[8 * t + i] *= alpha;
#pragma unroll
                            for (int dt = 0; dt < 2; ++dt)
#pragma unroll
                                for (int i = 0; i < 16; ++i) O[t][dt][i] *= alpha;
                        }
                        }
#pragma unroll
                        for (int i = 0; i < 16; ++i) S[i] = __builtin_amdgcn_exp2f(S[i]);
                        bf16x8 pf[2];
#pragma unroll
                        for (int s2 = 0; s2 < 2; ++s2) { u32x4 w; w.x = pk2(S[8 * s2], S[8 * s2 + 1]); w.y = pk2(S[8 * s2 + 2], S[8 * s2 + 3]);
                            w.z = pk2(S[8 * s2 + 4], S[8 * s2 + 5]); w.w = pk2(S[8 * s2 + 6], S[8 * s2 + 7]); pf[s2] = __builtin_bit_cast(bf16x8, w); }
#pragma unroll
                        for (int dt = 0; dt < 2; ++dt)
#pragma unroll
                            for (int s2 = 0; s2 < 2; ++s2) O[t][dt] = __builtin_amdgcn_mfma_f32_32x32x16_bf16(vf[dt][s2], pf[s2], O[t][dt], 0, 0, 0);
                        L = __builtin_amdgcn_mfma_f32_32x32x16_bf16(onesA[t], pf[0], L, 0, 0, 0);
                        L = __builtin_amdgcn_mfma_f32_32x32x16_bf16(onesA[t], pf[1], L, 0, 0, 0);
                    }
                }
                }
}
            if (tile < 64) { const int nb = buf ^ 1;
                *(u32x4*)(smem + nb * ATT_BUF + skey * ATT_ROWB + sch * 16) = kr; *(u32x4*)(smem + nb * ATT_BUF + ATT_KB + skey * ATT_ROWB + sch * 16) = vr; }
            __syncthreads();
        }
        l[0] = L[0]; l[1] = L[8];
        if (meta) {
            if (qsub != 0) {
#pragma unroll
                for (int t = 0; t < 2; ++t) { unsigned poff = (unsigned)((((hp * 3 + qsub - 1) * 2 + t) * 34) * 64 + lane) * 4u; asm volatile("" : "+v"(poff));
                    float* p = (float*)(smem + poff);
                    p[0] = negm[t][0]; p[64] = l[t];
#pragma unroll
                    for (int dt = 0; dt < 2; ++dt)
#pragma unroll
                        for (int i = 0; i < 16; ++i) p[(2 + dt * 16 + i) * 64] = O[t][dt][i]; }
            }
            __syncthreads();
            if (qsub == 0) {
#pragma unroll
                for (int t = 0; t < 2; ++t) {
                    unsigned p0off = (unsigned)(((hp * 3 * 2 + t) * 34) * 64 + lane) * 4u; asm volatile("" : "+v"(p0off));
                    const float* p0 = (const float*)(smem + p0off);
                    const float n0 = negm[t][0], n1 = p0[0], n2 = p0[(size_t)2 * 34 * 64], n3 = p0[(size_t)4 * 34 * 64];
                    const float ns = fminf(fminf(n0, n1), fminf(n2, n3));
                    const float f0 = __builtin_amdgcn_exp2f(ns - n0);
                    l[t] *= f0;
#pragma unroll
                    for (int dt = 0; dt < 2; ++dt)
#pragma unroll
                        for (int i = 0; i < 16; ++i) O[t][dt][i] *= f0;
#pragma unroll 1
                    for (int w = 0; w < 3; ++w) { const float* p = p0 + (size_t)(w * 2 * 34) * 64; const float fw = __builtin_amdgcn_exp2f(ns - p[0]);
                        l[t] += fw * p[64];
#pragma unroll
                        for (int dt = 0; dt < 2; ++dt)
#pragma unroll
                            for (int i = 0; i < 16; ++i) O[t][dt][i] += fw * p[(2 + dt * 16 + i) * 64]; }
                }
            }
            __syncthreads();
        }
        if (!meta || (qsub == 0 && r < 16)) {
#pragma unroll
            for (int t = 0; t < 2; ++t) {
                const float lt = l[t]; const float inv = 1.0f / lt;
                bf16_t* op = o + (size_t)qrow * DM + (kvh * 4 + hp * 2 + t) * 64 + (h ? 16 : 0);
#pragma unroll
                for (int dt = 0; dt < 2; ++dt)
#pragma unroll
                    for (int g = 0; g < 2; ++g) {
                        const unsigned a0 = pk2(O[t][dt][4 * g] * inv, O[t][dt][4 * g + 1] * inv), a1 = pk2(O[t][dt][4 * g + 2] * inv, O[t][dt][4 * g + 3] * inv);
                        const unsigned b0 = pk2(O[t][dt][4 * g + 8] * inv, O[t][dt][4 * g + 9] * inv), b1 = pk2(O[t][dt][4 * g + 10] * inv, O[t][dt][4 * g + 11] * inv);
                        const auto s0 = __builtin_amdgcn_permlane32_swap(a0, b0, false, false), s1 = __builtin_amdgcn_permlane32_swap(a1, b1, false, false);
                        u32x4 w; w.x = s0[0]; w.y = s1[0]; w.z = s0[1]; w.w = s1[1];
                        *(u32x4*)(op + 32 * dt + 8 * g) = w; }
            }
        }
    }
}


__device__ __forceinline__ void osm_update(f32x16& S, float& m, float& l, f32x16 (&O)[2]) {
    float mx = S[0];
#pragma unroll
    for (int i = 1; i < 16; ++i) mx = fmaxf(mx, S[i]);
    mx = fmaxf(mx, __shfl_xor(mx, 32));
    const float mn = fmaxf(m, mx), alpha = __builtin_amdgcn_exp2f(m - mn);
    m = mn;
    float rs = 0.f;
#pragma unroll
    for (int i = 0; i < 16; ++i) { S[i] = __builtin_amdgcn_exp2f(S[i] - mn); rs += S[i]; }
    l = l * alpha + rs;
#pragma unroll
    for (int dt = 0; dt < 2; ++dt)
#pragma unroll
        for (int i = 0; i < 16; ++i) O[dt][i] *= alpha;
}
__device__ __forceinline__ bf16x8 pack_p(const f32x16& S, int s2) {
    u32x4 w; w.x = pk2(S[8 * s2], S[8 * s2 + 1]); w.y = pk2(S[8 * s2 + 2], S[8 * s2 + 3]); w.z = pk2(S[8 * s2 + 4], S[8 * s2 + 5]); w.w = pk2(S[8 * s2 + 6], S[8 * s2 + 7]);
    return __builtin_bit_cast(bf16x8, w);
}
__device__ __forceinline__ void osm_lazy(f32x16& S, f32x16& negm, float& l, f32x16 (&O)[2], const bool first) {
    float mx = fmaxf(fmaxf(S[0], S[1]), S[2]);
#pragma unroll
    for (int i = 3; i < 15; i += 2) mx = fmaxf(fmaxf(mx, S[i]), S[i + 1]);
    mx = fmaxf(mx, S[15]);
    mx = fmaxf(mx, __shfl_xor(mx, 32));
    if (first || __ballot(mx > 8.0f) != 0ull) {
        const float d = first ? mx : fmaxf(mx, 0.f), alpha = first ? 1.0f : __builtin_amdgcn_exp2f(-d);
        l *= alpha;
#pragma unroll
        for (int i = 0; i < 16; ++i) { S[i] -= d; negm[i] -= d; }
#pragma unroll
        for (int dt = 0; dt < 2; ++dt)
#pragma unroll
            for (int i = 0; i < 16; ++i) O[dt][i] *= alpha;
    }
    f32x2_t rs2 = {0.f, 0.f};
#pragma unroll
    for (int i = 0; i < 16; i += 2) { S[i] = __builtin_amdgcn_exp2f(S[i]); S[i + 1] = __builtin_amdgcn_exp2f(S[i + 1]); rs2 += (f32x2_t){S[i], S[i + 1]}; }
    l += rs2.x + rs2.y;
}
__device__ __forceinline__ void osm_lazy_pair(f32x16& S0, f32x16& S1, f32x16& negm, float& l, f32x16 (&O)[2]) {
    float mx = fmaxf(fmaxf(S0[0], S0[1]), S0[2]), my = fmaxf(fmaxf(S1[0], S1[1]), S1[2]);
#pragma unroll
    for (int i = 3; i < 15; i += 2) { mx = fmaxf(fmaxf(mx, S0[i]), S0[i + 1]); my = fmaxf(fmaxf(my, S1[i]), S1[i + 1]); }
    mx = fmaxf(fmaxf(mx, S0[15]), fmaxf(my, S1[15]));
    mx = fmaxf(mx, __shfl_xor(mx, 32));
    if (__ballot(mx > 8.0f) != 0ull) {
        const float d = fmaxf(mx, 0.f), alpha = __builtin_amdgcn_exp2f(-d);
        l *= alpha;
#pragma unroll
        for (int i = 0; i < 16; ++i) { S0[i] -= d; S1[i] -= d; negm[i] -= d; }
#pragma unroll
        for (int dt = 0; dt < 2; ++dt)
#pragma unroll
            for (int i = 0; i < 16; ++i) O[dt][i] *= alpha;
    }
    float ra = 0.f, rb = 0.f, rc = 0.f, rd = 0.f;
#pragma unroll
    for (int i = 0; i < 16; i += 2) { S0[i] = __builtin_amdgcn_exp2f(S0[i]); S1[i] = __builtin_amdgcn_exp2f(S1[i]); S0[i + 1] = __builtin_amdgcn_exp2f(S0[i + 1]); S1[i + 1] = __builtin_amdgcn_exp2f(S1[i + 1]);
        ra += S0[i]; rb += S1[i]; rc += S0[i + 1]; rd += S1[i + 1]; }
    l += (ra + rb) + (rc + rd);
}
__device__ __forceinline__ void osm_lazy_pair2(f32x16& S0, f32x16& S1, f32x16& Ca, f32x16& Cb, float& l, f32x16 (&O)[2]) {
    float mx = fmaxf(fmaxf(S0[0], S0[1]), S0[2]), my = fmaxf(fmaxf(S1[0], S1[1]), S1[2]);
#pragma unroll
    for (int i = 3; i < 15; i += 2) { mx = fmaxf(fmaxf(mx, S0[i]), S0[i + 1]); my = fmaxf(fmaxf(my, S1[i]), S1[i + 1]); }
    mx = fmaxf(fmaxf(mx, S0[15]), fmaxf(my, S1[15]));
    mx = fmaxf(mx, __shfl_xor(mx, 32));
    if (__ballot(mx > 8.0f) != 0ull) {
        const float d = fmaxf(mx, 0.f), alpha = __builtin_amdgcn_exp2f(-d);
        l *= alpha;
#pragma unroll
        for (int i = 0; i < 16; ++i) { S0[i] -= d; S1[i] -= d; Ca[i] -= d; Cb[i] -= d; }
#pragma unroll
        for (int dt = 0; dt < 2; ++dt)
#pragma unroll
            for (int i = 0; i < 16; ++i) O[dt][i] *= alpha;
    }
    float ra = 0.f, rb = 0.f, rc = 0.f, rd = 0.f;
#pragma unroll
    for (int i = 0; i < 16; i += 2) { S0[i] = __builtin_amdgcn_exp2f(S0[i]); S1[i] = __builtin_amdgcn_exp2f(S1[i]); S0[i + 1] = __builtin_amdgcn_exp2f(S0[i + 1]); S1[i + 1] = __builtin_amdgcn_exp2f(S1[i + 1]);
        ra += S0[i]; rb += S1[i]; rc += S0[i + 1]; rd += S1[i + 1]; }
    l += (ra + rb) + (rc + rd);
}
__device__ __forceinline__ void osm_lazy2(f32x16& S, f32x16& Ca, f32x16& Cb, float& l, f32x16 (&O)[2], const bool first) {
    float mx = fmaxf(fmaxf(S[0], S[1]), S[2]);
#pragma unroll
    for (int i = 3; i < 15; i += 2) mx = fmaxf(fmaxf(mx, S[i]), S[i + 1]);
    mx = fmaxf(mx, S[15]);
    mx = fmaxf(mx, __shfl_xor(mx, 32));
    if (first || __ballot(mx > 8.0f) != 0ull) {
        const float d = first ? mx : fmaxf(mx, 0.f), alpha = first ? 1.0f : __builtin_amdgcn_exp2f(-d);
        l *= alpha;
#pragma unroll
        for (int i = 0; i < 16; ++i) { S[i] -= d; Ca[i] -= d; Cb[i] -= d; }
#pragma unroll
        for (int dt = 0; dt < 2; ++dt)
#pragma unroll
            for (int i = 0; i < 16; ++i) O[dt][i] *= alpha;
    }
    float ra = 0.f, rb = 0.f;
#pragma unroll
    for (int i = 0; i < 16; i += 2) { S[i] = __builtin_amdgcn_exp2f(S[i]); S[i + 1] = __builtin_amdgcn_exp2f(S[i + 1]); ra += S[i]; rb += S[i + 1]; }
    l += ra + rb;
}
constexpr int NA_TBL_OFF = 2 * ATT_BUF + 4096;
__device__ __forceinline__ void na_attn_fast(const Params& P, unsigned char* smem, const int tid) {
    const bf16_t* qk = (const bf16_t*)(P.ws + WS_BIG); const bf16_t* vt = (const bf16_t*)(P.ws + WS_VT); bf16_t* o = (bf16_t*)(P.ws + WS_H);
    const float* rpb = P.in[8]; const float* mbias = P.in[9];
    const int wave = tid >> 6, lane = tid & 63, r = lane & 31, h = lane >> 5;
    const int G = gridDim.x, bx = blockIdx.x;
    const int vb = (G % 8 == 0) ? (bx % 8) * (G / 8) + bx / 8 : bx;
    const int kapr = (r & ~12) | ((r & 4) << 1) | ((r & 8) >> 1);
    const int skey = tid >> 3, sch = tid & 7;
    float* tbl = (float*)(smem + NA_TBL_OFF);
    for (int i = tid; i < 16 * 465; i += NTHREADS) tbl[i] = rpb[i] * LOG2E;
    if (tid < 64) tbl[-64 + tid] = 0.f;
    else if (tid < 192) tbl[16 * 465 + (tid - 64)] = 0.f;
    __syncthreads();
    const int rr = wave >> 1, half = wave & 1, c = 32 * half + r, cs = min(max(c - 8, 0), 48), w0 = 8 * h - cs;
    f32x16 madd[2];
#pragma unroll
    for (int tl = 0; tl < 2; ++tl)
#pragma unroll
        for (int i = 0; i < 16; ++i) madd[tl][i] = ((unsigned)(32 * tl + 16 * (i >> 3) + (i & 7) + w0) < 16u) ? 0.f : -1e30f;
    for (int U = vb; U < 4096; U += G) {
        const int rgp = U & 15, hd = (U >> 4) & 15, b = U >> 8;
        const int R0 = 4 * rgp, rg = R0 + rr, rs = min(max(rg - 4, 0), 56);
        const int jlo = min(max(R0 - 4, 0), 56), nrows = min(max(R0 - 1, 0), 56) + 8 - jlo;
        const int qrow = b * 4096 + rg * 64 + c;
        bf16x8 qf[4];
#pragma unroll
        for (int s = 0; s < 4; ++s) qf[s] = *(const bf16x8*)(qk + (size_t)qrow * 2048 + hd * 64 + 16 * s + 8 * h);
        f32x16 O[2], cm[2], zero16; float l = 0.f;
#pragma unroll
        for (int i = 0; i < 16; ++i) { zero16[i] = 0.f; cm[0][i] = madd[0][i]; cm[1][i] = madd[1][i]; }
#pragma unroll
        for (int dt = 0; dt < 2; ++dt)
#pragma unroll
            for (int i = 0; i < 16; ++i) O[dt][i] = 0.f;
        const bf16_t* kbase = qk + 1024 + hd * 64 + sch * 8;
        const bf16_t* vbase = vt + (size_t)(hd * 64 + skey) * MTOK + sch * 8;
        u32x4 kr, vr;
        { const int krow0 = b * 4096 + jlo * 64;
          kr = *(const u32x4*)(kbase + (size_t)(krow0 + skey) * 2048); vr = *(const u32x4*)(vbase + krow0); }
        {
            const bf16_t* kp = qk + (size_t)(MREAL + b * 16 + (kapr & 15)) * 2048 + 1024 + hd * 64 + 8 * h;
            const bf16_t* vh = vt + (size_t)(hd * 64 + r) * MTOK + (MREAL + b * 16 + 8 * h);
            f32x16 S = __builtin_amdgcn_mfma_f32_32x32x16_bf16(*(const bf16x8*)(kp), qf[0], zero16, 0, 0, 0);
#pragma unroll
            for (int s = 1; s < 4; ++s) S = __builtin_amdgcn_mfma_f32_32x32x16_bf16(*(const bf16x8*)(kp + 16 * s), qf[s], S, 0, 0, 0);
            const f32x4 b0 = *(const f32x4*)(mbias + hd * 16 + 8 * h), b1 = *(const f32x4*)(mbias + hd * 16 + 8 * h + 4);
#pragma unroll
            for (int i = 0; i < 4; ++i) { S[i] += b0[i] * LOG2E; S[4 + i] += b1[i] * LOG2E; }
#pragma unroll
            for (int i = 8; i < 16; ++i) S[i] = -1e30f;
            osm_lazy2(S, cm[0], cm[1], l, O, true);
            const bf16x8 pf0 = pack_p(S, 0);
#pragma unroll
            for (int dt = 0; dt < 2; ++dt) O[dt] = __builtin_amdgcn_mfma_f32_32x32x16_bf16(*(const bf16x8*)(vh + (size_t)(dt * 32) * MTOK), pf0, O[dt], 0, 0, 0);
        }
        *(u32x4*)(smem + skey * ATT_ROWB + sch * 16) = kr; *(u32x4*)(smem + ATT_KB + skey * ATT_ROWB + sch * 16) = vr;
        __syncthreads();
        const float* tp = tbl + (hd * 465 + 8 * h - c + 15);
        for (int jj = 0; jj < nrows; ++jj) {
            const int j = jlo + jj, buf = jj & 1;
            if (jj + 1 < nrows) { const int krow0 = b * 4096 + (j + 1) * 64;
                kr = *(const u32x4*)(kbase + (size_t)(krow0 + skey) * 2048); vr = *(const u32x4*)(vbase + krow0); }
            if (j >= rs && j < rs + 8) {
                const unsigned char* Kb = smem + buf * ATT_BUF; const unsigned char* Vb = Kb + ATT_KB;
                const float* tpi = tp + 31 * (j - rg + 7);
                bf16x8 kf[2][4], vf[2][2][2];
#pragma unroll
                for (int tl = 0; tl < 2; ++tl) {
#pragma unroll
                    for (int s = 0; s < 4; ++s) kf[tl][s] = *(const bf16x8*)(Kb + (tl * 32 + kapr) * ATT_ROWB + (16 * s + 8 * h) * 2);
#pragma unroll
                    for (int dt = 0; dt < 2; ++dt)
#pragma unroll
                        for (int s2 = 0; s2 < 2; ++s2) vf[tl][dt][s2] = *(const bf16x8*)(Vb + (dt * 32 + r) * ATT_ROWB + (tl * 32 + 16 * s2 + 8 * h) * 2);
                }
                f32x16 S0 = __builtin_amdgcn_mfma_f32_32x32x16_bf16(kf[0][0], qf[0], cm[0], 0, 0, 0);
                f32x16 S1 = __builtin_amdgcn_mfma_f32_32x32x16_bf16(kf[1][0], qf[0], cm[1], 0, 0, 0);
#pragma unroll
                for (int s = 1; s < 4; ++s) { S0 = __builtin_amdgcn_mfma_f32_32x32x16_bf16(kf[0][s], qf[s], S0, 0, 0, 0); S1 = __builtin_amdgcn_mfma_f32_32x32x16_bf16(kf[1][s], qf[s], S1, 0, 0, 0); }
#pragma unroll
                for (int i = 0; i < 16; ++i) { const int kq0 = 16 * (i >> 3) + (i & 7); S0[i] += tpi[kq0]; S1[i] += tpi[32 + kq0]; }
                osm_lazy_pair2(S0, S1, cm[0], cm[1], l, O);
                { const bf16x8 p00 = pack_p(S0, 0), p01 = pack_p(S0, 1), p10 = pack_p(S1, 0), p11 = pack_p(S1, 1);
#pragma unroll
                  for (int dt = 0; dt < 2; ++dt) { O[dt] = __builtin_amdgcn_mfma_f32_32x32x16_bf16(vf[0][dt][0], p00, O[dt], 0, 0, 0);
                      O[dt] = __builtin_amdgcn_mfma_f32_32x32x16_bf16(vf[0][dt][1], p01, O[dt], 0, 0, 0);
                      O[dt] = __builtin_amdgcn_mfma_f32_32x32x16_bf16(vf[1][dt][0], p10, O[dt], 0, 0, 0);
                      O[dt] = __builtin_amdgcn_mfma_f32_32x32x16_bf16(vf[1][dt][1], p11, O[dt], 0, 0, 0); } }
            }
            if (jj + 1 < nrows) { const int nb = buf ^ 1;
                *(u32x4*)(smem + nb * ATT_BUF + skey * ATT_ROWB + sch * 16) = kr; *(u32x4*)(smem + nb * ATT_BUF + ATT_KB + skey * ATT_ROWB + sch * 16) = vr; }
            __syncthreads();
        }
        const float lt = l + __shfl_xor(l, 32), inv = 1.0f / lt;
        bf16_t* op = o + (size_t)qrow * DM + hd * 64 + 4 * h;
#pragma unroll
        for (int dt = 0; dt < 2; ++dt)
#pragma unroll
            for (int g = 0; g < 4; ++g) { const unsigned w0_ = pk2(O[dt][4 * g] * inv, O[dt][4 * g + 1] * inv), w1_ = pk2(O[dt][4 * g + 2] * inv, O[dt][4 * g + 3] * inv);
                *(unsigned long long*)(op + 32 * dt + 8 * g) = (unsigned long long)w0_ | ((unsigned long long)w1_ << 32); }
    }
    for (int u = vb * 8 + wave; u < 256; u += G * 8) {
        const int hd = u & 15, b = u >> 4;
        const int qrow = MREAL + b * 16 + (r & 15);
        f32x16 O[2], negm; float l = 0.f;
#pragma unroll
        for (int i = 0; i < 16; ++i) negm[i] = 0.f;
#pragma unroll
        for (int dt = 0; dt < 2; ++dt)
#pragma unroll
            for (int i = 0; i < 16; ++i) O[dt][i] = 0.f;
        const bf16_t* qp = qk + (size_t)qrow * 2048 + hd * 64 + 8 * h;
        const bf16_t* kp = qk + (size_t)(MREAL + b * 16 + (kapr & 15)) * 2048 + 1024 + hd * 64 + 8 * h;
        const bf16_t* vh = vt + (size_t)(hd * 64 + r) * MTOK + (MREAL + b * 16 + 8 * h);
        f32x16 S = __builtin_amdgcn_mfma_f32_32x32x16_bf16(*(const bf16x8*)(kp), *(const bf16x8*)(qp), negm, 0, 0, 0);
#pragma unroll
        for (int s = 1; s < 4; ++s) S = __builtin_amdgcn_mfma_f32_32x32x16_bf16(*(const bf16x8*)(kp + 16 * s), *(const bf16x8*)(qp + 16 * s), S, 0, 0, 0);
#pragma unroll
        for (int i = 8; i < 16; ++i) S[i] = -1e30f;
        osm_lazy(S, negm, l, O, true);
        const bf16x8 pf0 = pack_p(S, 0);
#pragma unroll
        for (int dt = 0; dt < 2; ++dt) O[dt] = __builtin_amdgcn_mfma_f32_32x32x16_bf16(*(const bf16x8*)(vh + (size_t)(dt * 32) * MTOK), pf0, O[dt], 0, 0, 0);
        const float lt = l + __shfl_xor(l, 32);
        if (r < 16) {
            const float inv = 1.0f / lt;
            bf16_t* op = o + (size_t)qrow * DM + hd * 64 + 4 * h;
#pragma unroll
            for (int dt = 0; dt < 2; ++dt)
#pragma unroll
                for (int g = 0; g < 4; ++g) { const unsigned w0_ = pk2(O[dt][4 * g] * inv, O[dt][4 * g + 1] * inv), w1_ = pk2(O[dt][4 * g + 2] * inv, O[dt][4 * g + 3] * inv);
                    *(unsigned long long*)(op + 32 * dt + 8 * g) = (unsigned long long)w0_ | ((unsigned long long)w1_ << 32); }
        }
    }
}

#define LAS __attribute__((address_space(3)))
#define XB_TMO      128
#define XB_XCNT(j)  (256  + 64 * (j))
#define XB_XSUB(j)  (1280 + 64 * (j))
#define XB_XGEN(j)  (2304 + 64 * (j))
#define XB_TOP      3328
#define XB_TOPGEN   3392
#define XCD_BAR_WORDS 3456
#define XB_SPIN_CAP (1u << 18)

__device__ __forceinline__ unsigned xb_ld(unsigned* p)              { return __hip_atomic_load(p, __ATOMIC_RELAXED, __HIP_MEMORY_SCOPE_AGENT); }
__device__ __forceinline__ unsigned xb_add(unsigned* p, unsigned v) { return __hip_atomic_fetch_add(p, v, __ATOMIC_RELAXED, __HIP_MEMORY_SCOPE_AGENT); }
__device__ __forceinline__ unsigned xb_xcc_id() { return (unsigned)__builtin_amdgcn_s_getreg((3 << 11) | 20) & 0xFu; }
#define XB_SPIN(cond, bar) do { unsigned _sp = 0; while (cond) { __builtin_amdgcn_s_sleep(1); \
    if ((++_sp & 255u) == 0u) { if (xb_ld(&(bar)[XB_TMO])) break; if (_sp > XB_SPIN_CAP) { atomicAdd(&(bar)[XB_TMO], 1u); break; } } } } while (0)

struct XcdBarrier {
    unsigned* bar; unsigned x;
    volatile LAS unsigned* st;
};

__device__ __forceinline__ XcdBarrier xcd_barrier_post(unsigned* bar, volatile LAS unsigned* st) {
    XcdBarrier b; b.bar = bar; b.x = xb_xcc_id(); b.st = st;
    if (threadIdx.x == 0) (void)xb_add(&bar[XB_XCNT(b.x)], 1u);
    return b;
}
__device__ __forceinline__ void xcd_barrier_complete(unsigned* bar, unsigned x, unsigned& nloc, unsigned& nx) {
    const unsigned G = gridDim.x * gridDim.y * gridDim.z;
    unsigned sum, cnt, mine, sp = 0u;
    for (;;) {
        sum = 0u; cnt = 0u; mine = 0u;
#pragma unroll
        for (unsigned j = 0; j < 16; ++j) { const unsigned c = xb_ld(&bar[XB_XCNT(j)]); sum += c; cnt += (c > 0u) ? 1u : 0u; mine = (j == x) ? c : mine; }
        if (sum == G) break;
        __builtin_amdgcn_s_sleep(1);
        if ((++sp & 255u) == 0u) { if (xb_ld(&bar[XB_TMO])) break; if (sp > XB_SPIN_CAP) { atomicAdd(&bar[XB_TMO], 1u); break; } }
    }
    nloc = mine > 0u ? mine : 1u; nx = cnt > 0u ? cnt : 1u;
}

__device__ __forceinline__ void xcd_barrier(const XcdBarrier& b) {
    asm volatile("s_waitcnt vmcnt(0)" ::: "memory");
    __syncthreads();
    if (threadIdx.x == 0) {
        unsigned* bar = b.bar;
        __builtin_amdgcn_s_waitcnt(0);
        unsigned nloc = b.st[0], nx = b.st[1];
        if (nloc == 0u) { xcd_barrier_complete(bar, b.x, nloc, nx); b.st[0] = nloc; b.st[1] = nx; }
        const unsigned old = xb_add(&bar[XB_XSUB(b.x)], 1u);
        const unsigned gen = old / nloc;
        if (old + 1u == (gen + 1u) * nloc) {
            __builtin_amdgcn_fence(__ATOMIC_RELEASE, "agent");
            asm volatile("s_waitcnt vmcnt(0)" ::: "memory");
            const unsigned og = xb_add(&bar[XB_TOP], 1u);
            const unsigned tg = og / nx;
            if (og + 1u == (tg + 1u) * nx) xb_add(&bar[XB_TOPGEN], 1u);
            else XB_SPIN(xb_ld(&bar[XB_TOPGEN]) == tg, bar);
            __builtin_amdgcn_fence(__ATOMIC_ACQUIRE, "agent");
            xb_add(&bar[XB_XGEN(b.x)], 1u);
            asm volatile("s_waitcnt vmcnt(0)" ::: "memory");
        } else {
            XB_SPIN(xb_ld(&bar[XB_XGEN(b.x)]) == gen, bar);
            __builtin_amdgcn_fence(__ATOMIC_ACQUIRE, "agent");
            asm volatile("s_waitcnt vmcnt(0)" ::: "memory");
        }
    }
    __syncthreads();
}

#if MK_ONE_LAUNCH
#define GRID_SYNC() do { XcdBarrier xb_; xb_.bar = (unsigned*)P.ws; xb_.x = xb_xcc_id(); xb_.st = (volatile LAS unsigned*)(lds + XB_LDS_OFF); xcd_barrier(xb_); } while (0)
#else
#define GRID_SYNC() do {} while (0)
#endif
constexpr int XB_LDS_OFF = 131072;
constexpr size_t XB_WS_BYTES = 16384;
constexpr int N_PHASES = 21;
__global__ void __launch_bounds__(NTHREADS, 2) mk_fwd(Params P) {
    extern __shared__ __attribute__((aligned(16))) unsigned char smem[];
    PG8_LAS unsigned char* lds = (PG8_LAS unsigned char*)smem;
    const int G = gridDim.x, bx = blockIdx.x;
#if MK_ONE_LAUNCH
    if (threadIdx.x == 0) { ((volatile LAS unsigned*)(lds + XB_LDS_OFF))[0] = 0u; ((volatile LAS unsigned*)(lds + XB_LDS_OFF))[1] = 0u; }
    if (blockIdx.x == 0) for (int i = threadIdx.x; i < XCD_BAR_WORDS; i += NTHREADS) ((unsigned*)P.ws)[i] = 0u;
    __syncthreads();
#endif
    if (P.ph_lo == 0) {
        int tid = threadIdx.x; asm volatile("" : "+v"(tid));
        p0_weights(P, smem, tid);
        nr_phase(P, true, false, false, false, 0.f, P.in[2], P.in[2], tid);
#if MK_ONE_LAUNCH
        if (1 < P.ph_hi) cg::this_grid().sync();
        (void)xcd_barrier_post((unsigned*)P.ws, (volatile LAS unsigned*)(lds + XB_LDS_OFF));
#endif
    }
    for (int ph = (P.ph_lo == 0 ? 1 : P.ph_lo); ph < P.ph_hi; ++ph) {
        int tid = threadIdx.x; asm volatile("" : "+v"(tid));
        unsigned char* ws = P.ws; asm volatile("" : "+s"(ws));
        unsigned char* W = ws + WS_W;
        bf16_t* xn = (bf16_t*)(ws + WS_XN); bf16_t* yb = (bf16_t*)(ws + WS_Y); bf16_t* big = (bf16_t*)(ws + WS_BIG); bf16_t* vt = (bf16_t*)(ws + WS_VT);
        float* ssqp = (float*)(ws + WS_SSQ);
        const float* gains = P.in[2];
        {
            const int l = (ph - 1) / 10, s = (ph - 1) % 10;
            const float* gl = gains + (size_t)l * 6 * DM;
            if (s == 0 || s == 7) {
                const int lj = l * 2 + (s == 7);
                pg8::Gemm g{xn, (const bf16_t*)(W + lj * W_FFN_BYTES), MTOK, 2 * FF, DM}; pg8::StaticOrder S; S.init(MTOK, 2 * FF, G, bx);
                EpiSwiGLU E{big};
                pg8::gemm_phase<EpiSwiGLU, pg8::StaticOrder, true, true>(lds, g, S, E, tid);
            } else if (s == 1 || s == 5 || s == 8) {
                pg8::Gemm g; g.M = MREAL; g.N = DM;
                if (s == 5) { g.A = (const bf16_t*)(ws + WS_H); g.Bt = (const bf16_t*)(W + (l == 0 ? W_NA_O : W_GQA_O)); g.K = DM; }
                else { g.A = big; g.Bt = (const bf16_t*)(W + (l * 2 + (s == 8)) * W_FFN_BYTES + W_GU_BYTES); g.K = FF; }
                pg8::StaticOrder S; S.init(MREAL, DM, G, bx);
                EpiY E{yb, ssqp};
                pg8::gemm_phase<EpiY, pg8::StaticOrder, true, true>(lds, g, S, E, tid);
                { int tid2 = threadIdx.x; asm volatile("" : "+v"(tid2));
                  meta_gemm_y(g.A, g.Bt, g.K, yb, ssqp, smem, tid2); }
            } else if (s == 2) nr_phase(P, l == 0, true, true, false, 0.5f, gl + 1 * DM, gl + 2 * DM, tid);
            else if (s == 6) nr_phase(P, false, true, true, false, 1.0f, gl + 3 * DM, gl + 4 * DM, tid);
            else if (s == 9) nr_phase(P, false, true, true, l == 1, 0.5f, gl + 5 * DM, gains + (size_t)((l + 1) % 2) * 6 * DM, tid);
            else if (s == 3) {
                const float* rc = (const float*)(ws + WS_ROPE);
                if (l == 0) {
                    pg8::Gemm g{xn, (const bf16_t*)(W + W_NA_QK), MTOK, 2048, DM}; pg8::StaticOrder S; S.init(MTOK, 2048, G, bx);
                    EpiQK<false> E{big, 2048, 0.125f * LOG2E, nullptr, nullptr, nullptr, nullptr};
                    pg8::gemm_phase<EpiQK<false>, pg8::StaticOrder, true, true>(lds, g, S, E, tid);
                } else {
                    pg8::Gemm g{xn, (const bf16_t*)(W + W_GQA_QK), MTOK, 1280, DM}; pg8::StaticOrder S; S.init(MTOK, 1280, G, bx);
                    EpiQK<true> E{big, 1280, 0.125f * LOG2E, P.in[12], P.in[13], rc, rc + 1024};
                    pg8::gemm_phase<EpiQK<true>, pg8::StaticOrder, true, true>(lds, g, S, E, tid);
                }
                { const int mv = (l == 0) ? 1024 : 256;
                  int tid = threadIdx.x; asm volatile("" : "+v"(tid));
                  pg8::Gemm g{(const bf16_t*)(W + (l == 0 ? W_NA_V : W_GQA_V)), xn, mv, MTOK, DM}; pg8::StaticOrder S; S.init(mv, MTOK, G, bx);
                  EpiPlain E{vt, (size_t)MTOK};
                  pg8::gemm_phase<EpiPlain, pg8::StaticOrder, true, true>(lds, g, S, E, tid); }
            } else {

#ifndef NO_ATTN
                if (l == 0) {
#if NA_FAST
                    na_attn_fast(P, smem, tid);
#else
                    na_attn_naive(P, tid);
#endif
                } else {
#if GQA_FAST
                    {
                        const int ln = tid & 63;
                        float gq = fabsf(P.in[12][ln]), gk = fabsf(P.in[13][ln]);
#pragma unroll
                        for (int o = 32; o >= 1; o >>= 1) { gq = fmaxf(gq, __shfl_xor(gq, o)); gk = fmaxf(gk, __shfl_xor(gk, o)); }
                        const float bnd = 8.0f * LOG2E * gq * gk * 1.02f + 0.5f;
                        if (bnd < 50.0f) gqa_attn_fast<true>(P, smem, tid, bnd); else gqa_attn_fast<false>(P, smem, tid, 0.f);
                    }
#else
                    gqa_attn_naive(P, tid);
#endif
                }
#endif

            }
        }
        if (ph + 1 < P.ph_hi) GRID_SYNC();
    }
}

extern "C" void kernel_launch(void* const* d_in, const int* in_sizes, int n_in, void* d_out, int out_size, void* d_ws, size_t ws_size, hipStream_t stream) {
    static int grid = 0;
    if (grid == 0) {
        if (n_in != 14 || out_size != MREAL * DM || ws_size < WS_END) { fprintf(stderr, "kernel_launch: unexpected shapes (n_in %d out %d ws %zu)\n", n_in, out_size, ws_size); grid = -1; return; }
        int dev = 0, cus = 0, per_cu = 0;
        hipGetDevice(&dev); hipDeviceGetAttribute(&cus, hipDeviceAttributeMultiprocessorCount, dev);
        if (hipFuncSetAttribute((const void*)mk_fwd, hipFuncAttributeMaxDynamicSharedMemorySize, LDS_BYTES) != hipSuccess) { fprintf(stderr, "kernel_launch: hipFuncSetAttribute failed\n"); grid = -1; return; }
        if (hipOccupancyMaxActiveBlocksPerMultiprocessor(&per_cu, (const void*)mk_fwd, NTHREADS, LDS_BYTES) != hipSuccess || per_cu < 1) { fprintf(stderr, "kernel_launch: occupancy query gave %d\n", per_cu); per_cu = 1; }
        (void)hipGetLastError();
        grid = cus * per_cu;
    }
    if (grid < 0) return;
    Params p{};
    for (int i = 0; i < 14; ++i) p.in[i] = (const float*)d_in[i];
    p.out = (float*)d_out; p.ws = (unsigned char*)d_ws;
#if MK_ONE_LAUNCH
    p.ph_lo = 0; p.ph_hi = N_PHASES;
    void* args[] = {&p};
    hipError_t e = hipLaunchCooperativeKernel((const void*)mk_fwd, dim3(grid), dim3(NTHREADS), args, LDS_BYTES, stream);
    if (e != hipSuccess) fprintf(stderr, "cooperative launch failed: %s (grid %d)\n", hipGetErrorString(e), grid);
#else
    for (int ph = 0; ph < N_PHASES; ++ph) {
        p.ph_lo = ph; p.ph_hi = ph + 1;
        for (int rep = 0; rep < (int)((DUP_MASK >> ph) & 1u) + 1; ++rep)
            hipLaunchKernelGGL(mk_fwd, dim3(grid), dim3(NTHREADS), LDS_BYTES, stream, p);
    }
#endif
}
```
